# Optimizing an MI355X kernel written in HIP

```python
import jax, jax.numpy as jnp
from jax import lax
import numpy as np

D_MODEL = 1024
BATCH = 8
SEQ = 2048
DEPTH = 4

GLA_HEADS = 4
GLA_DK = D_MODEL // 2
GLA_DV = D_MODEL
GLA_HK = GLA_DK // GLA_HEADS
GLA_HV = GLA_DV // GLA_HEADS
GLA_RANK = 16
GLA_GATE_NORM = 16.0
GLA_CHUNK = 64
SWA_HEADS = 16
SWA_KV_HEADS = 2
HEAD_DIM = 64
SWA_GROUP = SWA_HEADS // SWA_KV_HEADS
SWA_DQ = SWA_HEADS * HEAD_DIM
SWA_DKV = SWA_KV_HEADS * HEAD_DIM
WINDOW = 128
ROPE_THETA = 10000.0
N_EXPERTS = 16
N_GROUPS = 4
EXPERTS_PER_GROUP = N_EXPERTS // N_GROUPS
TOP_K = 2
D_EXPERT = 512
N_MOD = 6
EPS = 1e-6

IN_SPLITS = (GLA_DK, GLA_DK, GLA_DV, GLA_DV, GLA_RANK, SWA_DQ, SWA_DKV, SWA_DKV, D_MODEL, D_MODEL)
D_IN = 2 * GLA_DK + 2 * GLA_DV + GLA_RANK + SWA_DQ + 2 * SWA_DKV + 2 * D_MODEL

kernel_name = "hybrid_gla_swa_sinks_grouped_moe_adaln"


def rmsnorm(x, g):
    x32 = x.astype(jnp.float32)
    y = x32 * lax.rsqrt(jnp.mean(x32 * x32, axis=-1, keepdims=True) + EPS)
    return (y * g.astype(jnp.float32)).astype(x.dtype)


def rope(x, pos):
    half = HEAD_DIM // 2
    inv_freq = jnp.power(ROPE_THETA, -jnp.arange(half, dtype=jnp.float32) / half)
    ang = pos.astype(jnp.float32)[..., None] * inv_freq
    cos = jnp.cos(ang)[:, :, None, :]
    sin = jnp.sin(ang)[:, :, None, :]
    x32 = x.astype(jnp.float32)
    x1, x2 = x32[..., :half], x32[..., half:]
    return jnp.concatenate([x1 * cos - x2 * sin, x2 * cos + x1 * sin], axis=-1).astype(x.dtype)


def gla_chunked(q, k, v, g):
    B, S, H, _ = q.shape
    nc = S // GLA_CHUNK

    def to_chunks(t):
        return t.astype(jnp.float32).reshape(B, nc, GLA_CHUNK, H, t.shape[-1]).transpose(1, 0, 3, 2, 4)

    q, k, v, g = to_chunks(q) * GLA_HK ** -0.5, to_chunks(k), to_chunks(v), to_chunks(g)
    b = jnp.cumsum(g, axis=-2)
    b_last = b[..., -1:, :]
    q_e = q * jnp.exp(b)
    k_intra = k * jnp.exp(-b)
    k_state = k * jnp.exp(b_last - b)
    causal = jnp.tril(jnp.ones((GLA_CHUNK, GLA_CHUNK), dtype=bool))
    att = jnp.where(causal, jnp.einsum('nbhtd,nbhsd->nbhts', q_e, k_intra), 0.0)
    o_intra = jnp.einsum('nbhts,nbhsv->nbhtv', att, v)
    decay = jnp.exp(b_last[..., 0, :])

    def step(state, inp):
        q_n, k_n, v_n, d_n = inp
        o_n = jnp.einsum('bhtd,bhdv->bhtv', q_n, state)
        state = d_n[..., None] * state + jnp.einsum('bhsd,bhsv->bhdv', k_n, v_n)
        return state, o_n

    s0 = jnp.zeros((B, H, GLA_HK, GLA_HV), jnp.float32)
    _, o_inter = lax.scan(step, s0, (q_e, k_state, v, decay))
    o = o_intra + o_inter
    return o.transpose(1, 0, 3, 2, 4).reshape(B, S, H, GLA_HV)


def swa_with_sinks(q, k, v, sinks):
    B, S = q.shape[0], q.shape[1]
    nb = S // WINDOW
    qb = q.astype(jnp.float32).reshape(B, nb, WINDOW, SWA_KV_HEADS, SWA_GROUP, HEAD_DIM) * HEAD_DIM ** -0.5
    kb = k.astype(jnp.float32).reshape(B, nb, WINDOW, SWA_KV_HEADS, HEAD_DIM)
    vb = v.astype(jnp.float32).reshape(B, nb, WINDOW, SWA_KV_HEADS, HEAD_DIM)

    def with_prev(t):
        prev = jnp.pad(t[:, :-1], ((0, 0), (1, 0), (0, 0), (0, 0), (0, 0)))
        return jnp.concatenate([prev, t], axis=2)

    kk, vv = with_prev(kb), with_prev(vb)
    s = jnp.einsum('bnqhgd,bnkhd->bhgnqk', qb, kk)
    qi = jnp.arange(WINDOW)[:, None]
    kj = jnp.arange(2 * WINDOW)[None, :]
    diff = WINDOW + qi - kj
    blk = jnp.arange(nb)[:, None, None]
    valid = (diff >= 0) & (diff < WINDOW) & (blk * WINDOW + kj - WINDOW >= 0)
    s = jnp.where(valid, s, -jnp.inf)
    sink = sinks.astype(jnp.float32).reshape(SWA_KV_HEADS, SWA_GROUP)[:, :, None, None, None]
    m = jnp.maximum(s.max(axis=-1, keepdims=True), sink)
    p = jnp.exp(s - m)
    denom = p.sum(axis=-1, keepdims=True) + jnp.exp(sink - m)
    o = jnp.einsum('bhgnqk,bnkhd->bnqhgd', p / denom, vv)
    return o.reshape(B, S, SWA_DQ)


def token_mixer(h, pos, w_in, a_w, a_b, gla_g, sinks, w_pa, w_pb, w_out):
    B, S, _ = h.shape
    split_points = [int(i) for i in np.cumsum(IN_SPLITS)[:-1]]
    q_a, k_a, v_a, r_a, lr_a, q_b, k_b, v_b, gt_a, gt_b = jnp.split(h @ w_in, split_points, axis=-1)

    def heads(t, d):
        return t.reshape(B, S, -1, d)

    g_a = jax.nn.log_sigmoid((lr_a @ a_w + a_b).astype(jnp.float32)) / GLA_GATE_NORM
    o_a = gla_chunked(heads(q_a, GLA_HK), heads(k_a, GLA_HK), heads(v_a, GLA_HV), heads(g_a, GLA_HK))
    o_a = rmsnorm(o_a, gla_g).astype(h.dtype).reshape(B, S, GLA_DV)
    y_a = o_a * jax.nn.silu(r_a)

    qr = rope(heads(q_b, HEAD_DIM), pos)
    kr = rope(heads(k_b, HEAD_DIM), pos)
    y_b = swa_with_sinks(qr, kr, heads(v_b, HEAD_DIM), sinks).astype(h.dtype)

    merged = jax.nn.sigmoid(gt_a) * (y_a @ w_pa) + jax.nn.sigmoid(gt_b) * (y_b @ w_pb)
    return merged @ w_out


def grouped_moe(h, router_w, router_b, w_gate, w_up, w_down):
    B, S, D = h.shape
    t = h.reshape(B * S, D)
    scores = jax.nn.sigmoid((t @ router_w).astype(jnp.float32))
    biased = scores + router_b.astype(jnp.float32)
    grp_scores = lax.top_k(biased.reshape(-1, N_GROUPS, EXPERTS_PER_GROUP), TOP_K)[0].sum(-1)
    grp = jnp.argmax(grp_scores, axis=-1)
    in_grp = (jnp.arange(N_EXPERTS) // EXPERTS_PER_GROUP)[None, :] == grp[:, None]
    _, idx = lax.top_k(jnp.where(in_grp, biased, -jnp.inf), TOP_K)
    w_sel = jnp.take_along_axis(scores, idx, axis=-1)
    w_sel = w_sel / w_sel.sum(axis=-1, keepdims=True)
    combine = jnp.sum(jax.nn.one_hot(idx, N_EXPERTS, dtype=jnp.float32) * w_sel[..., None], axis=1)
    hid = jax.nn.silu(jnp.einsum('nd,edf->nef', t, w_gate)) * jnp.einsum('nd,edf->nef', t, w_up)
    hid = hid * combine[..., None].astype(hid.dtype)
    out = jnp.einsum('nef,efd->nd', hid, w_down)
    return out.reshape(B, S, D)


def setup_inputs(seed: int = 0) -> dict:
    key = jax.random.key(seed)
    ks = jax.random.split(key, 21)
    L, D, E, F = DEPTH, D_MODEL, N_EXPERTS, D_EXPERT
    nrm = jax.random.normal
    return {
        "x": nrm(ks[0], (BATCH, SEQ, D), jnp.float32),
        "c": nrm(ks[1], (BATCH, D), jnp.float32),
        "positions": jnp.broadcast_to(jnp.arange(SEQ, dtype=jnp.int32), (BATCH, SEQ)),
        "ada_w": nrm(ks[2], (L, D, N_MOD * D), jnp.float32) * (0.3 * D ** -0.5),
        "ada_b": nrm(ks[3], (L, N_MOD * D), jnp.float32) * 0.01,
        "norm1_g": 1.0 + 0.05 * nrm(ks[4], (L, D), jnp.float32),
        "norm2_g": 1.0 + 0.05 * nrm(ks[5], (L, D), jnp.float32),
        "final_g": 1.0 + 0.05 * nrm(ks[6], (D,), jnp.float32),
        "w_in": nrm(ks[7], (L, D, D_IN), jnp.float32) * D ** -0.5,
        "gla_alpha_w": nrm(ks[8], (L, GLA_RANK, GLA_DK), jnp.float32) * GLA_RANK ** -0.5,
        "gla_alpha_b": 0.1 * nrm(ks[9], (L, GLA_DK), jnp.float32),
        "gla_norm_g": 1.0 + 0.05 * nrm(ks[10], (L, GLA_HV), jnp.float32),
        "swa_sinks": nrm(ks[11], (L, SWA_HEADS), jnp.float32),
        "w_pa": nrm(ks[12], (L, GLA_DV, D), jnp.float32) * GLA_DV ** -0.5,
        "w_pb": nrm(ks[13], (L, SWA_DQ, D), jnp.float32) * SWA_DQ ** -0.5,
        "w_out": nrm(ks[14], (L, D, D), jnp.float32) * D ** -0.5,
        "router_w": nrm(ks[15], (D, E), jnp.float32) * D ** -0.5,
        "router_b": 0.01 * nrm(ks[16], (E,), jnp.float32),
        "moe_w_gate": nrm(ks[17], (L, E, D, F), jnp.float32) * D ** -0.5,
        "moe_w_up": nrm(ks[18], (L, E, D, F), jnp.float32) * D ** -0.5,
        "moe_w_down": nrm(ks[19], (L, E, F, D), jnp.float32) * F ** -0.5,
    }


def reference(x, c, positions, ada_w, ada_b, norm1_g, norm2_g, final_g, w_in, gla_alpha_w, gla_alpha_b,
              gla_norm_g, swa_sinks, w_pa, w_pb, w_out, router_w, router_b, moe_w_gate, moe_w_up, moe_w_down):
    cond = jax.nn.silu(c)
    for l in range(DEPTH):
        mod = (cond @ ada_w[l] + ada_b[l])[:, None, :]
        sh1, sc1, g1, sh2, sc2, g2 = jnp.split(mod, N_MOD, axis=-1)
        h = rmsnorm(x, norm1_g[l]) * (1.0 + sc1) + sh1
        x = x + g1 * token_mixer(h, positions, w_in[l], gla_alpha_w[l], gla_alpha_b[l], gla_norm_g[l],
                                 swa_sinks[l], w_pa[l], w_pb[l], w_out[l])
        h = rmsnorm(x, norm2_g[l]) * (1.0 + sc2) + sh2
        x = x + g2 * grouped_moe(h, router_w, router_b, moe_w_gate[l], moe_w_up[l], moe_w_down[l])
    return rmsnorm(x, final_g)
```

```cpp
#include <hip/hip_runtime.h>
#include <stdint.h>
#include <stdio.h>

typedef unsigned short bf16;
typedef float f32x4 __attribute__((ext_vector_type(4)));
typedef unsigned u32x4 __attribute__((ext_vector_type(4)));
typedef unsigned u32x2 __attribute__((ext_vector_type(2)));
#define LAS __attribute__((address_space(3)))

constexpr int NB = 8, SEQ = 2048, DM = 1024, NL = 4, NTOK = NB * SEQ;
constexpr int GH = 4, GHK = 128, GHV = 256, GDK = 512, GDV = 1024, GCH = 64;
constexpr int SH = 16, SKV = 2, HD = 64, SDQ = 1024, SDKV = 128, WIN = 128;
constexpr int NE = 16, FE = 512;
constexpr int DIN = 6416, NMOD = 6144;
constexpr int C_QA = 0, C_KA = 512, C_VA = 1024, C_RA = 2048, C_LR = 3072, C_QB = 3088, C_KB = 4112, C_VB = 4240, C_GTA = 4368, C_GTB = 5392;
constexpr float EPS = 1e-6f;

constexpr size_t MiB = 1u << 20;
constexpr size_t WS_CTL = 0;
constexpr size_t WS_MOD = 1 * MiB;
constexpr size_t WS_ROPE = 2 * MiB;
constexpr size_t WS_RE = 6 * MiB;
constexpr size_t WS_RW = 6 * MiB + 256 * 1024;
constexpr size_t WS_RS = 6 * MiB + 512 * 1024;
constexpr size_t WS_ROWIDX = 7 * MiB;
constexpr size_t WS_LR = 8 * MiB;
constexpr size_t WS_DEC = 9 * MiB;
constexpr size_t WS_X = 16 * MiB;
constexpr size_t WS_H = 80 * MiB;
constexpr size_t WS_QA = 112 * MiB;
constexpr size_t WS_KA = 128 * MiB;
constexpr size_t WS_GA = 144 * MiB;
constexpr size_t WS_VA = 176 * MiB;
constexpr size_t WS_RA = 208 * MiB;
constexpr size_t WS_QB = 240 * MiB;
constexpr size_t WS_KB = 272 * MiB;
constexpr size_t WS_VB = 276 * MiB;
constexpr size_t WS_GTA = 280 * MiB;
constexpr size_t WS_GTB = 312 * MiB;
constexpr size_t WS_OI = 344 * MiB;
constexpr size_t WS_HID = 112 * MiB;
constexpr size_t WS_Y = 150 * MiB;
constexpr size_t WS_W = 408 * MiB;
constexpr size_t WS_END = 680 * MiB;

constexpr int CW_CNT = 1024;
constexpr size_t CTL_BYTES = 1 * MiB;

__device__ __forceinline__ float bf2f(bf16 b) { return __uint_as_float(((unsigned)b) << 16); }
__device__ __forceinline__ bf16 f2bf(float f) { unsigned u = __float_as_uint(f); u += 0x7fffu + ((u >> 16) & 1u); return (bf16)(u >> 16); }
__device__ __forceinline__ unsigned pk2(float lo, float hi) { return (unsigned)f2bf(lo) | ((unsigned)f2bf(hi) << 16); }
__device__ __forceinline__ float lo16(unsigned u) { return __uint_as_float(u << 16); }
__device__ __forceinline__ float hi16(unsigned u) { return __uint_as_float(u & 0xffff0000u); }
__device__ __forceinline__ float wave_sum(float v) {
#pragma unroll
    for (int o = 1; o < 64; o <<= 1) v += __shfl_xor(v, o);
    return v;
}
__device__ __forceinline__ float shx(float v, int mask, int lane) { return __builtin_bit_cast(float, __builtin_amdgcn_ds_bpermute((lane ^ mask) << 2, __builtin_bit_cast(int, v))); }
__device__ __forceinline__ int shx_i(int v, int mask, int lane) { return __builtin_amdgcn_ds_bpermute((lane ^ mask) << 2, v); }
__device__ __forceinline__ int shl_from(int v, int src) { return __builtin_amdgcn_ds_bpermute(src << 2, v); }
__device__ __forceinline__ float wave_sum(float v, int lane) {
#pragma unroll
    for (int o = 1; o < 64; o <<= 1) v += shx(v, o, lane);
    return v;
}
__device__ __forceinline__ float wave_max(float v) {
#pragma unroll
    for (int o = 1; o < 64; o <<= 1) v = fmaxf(v, __shfl_xor(v, o));
    return v;
}
__device__ __forceinline__ float sigmoidf_(float x) { return __builtin_amdgcn_rcpf(1.f + __expf(-x)); }
__device__ __forceinline__ float siluf_(float x) { return x * __builtin_amdgcn_rcpf(1.f + __expf(-x)); }
__device__ __forceinline__ float logsigmoidf_(float x) { return fminf(x, 0.f) - log1pf(__expf(-fabsf(x))); }

struct P {
    const float *x, *c; const int* pos;
    const float *ada_w, *ada_b, *n1g, *n2g, *fg, *w_in, *aw, *ab, *glag, *sinks, *w_pa, *w_pb, *w_out, *rw, *rb, *wg, *wu, *wd;
    float* out; unsigned char* ws;
};

__device__ __forceinline__ void rope_entry(const int* pos, float2* tab, int idx) {
    const int tok = idx >> 5, j = idx & 31;
    double inv = 1.0; for (int i = 0; i < j; ++i) inv *= 0.74989420933245582;
    const double rev = (double)pos[tok] * inv * 0.15915494309189535;
    const float fr = (float)(rev - rint(rev));
    tab[idx] = make_float2(__builtin_amdgcn_cosf(fr), __builtin_amdgcn_sinf(fr));
}

__device__ __forceinline__ void row_load(const float* xin, int m, int lane, f32x4 (&v)[4]) {
#pragma unroll
    for (int j = 0; j < 4; ++j) v[j] = *(const f32x4*)(xin + (size_t)m * DM + 256 * j + 4 * lane);
}
__device__ __forceinline__ void token_row(const P& p, int l, int m, int lane, int mode, const f32x4 (&vin)[4], const float* ng, const float* sc, const float* sh, const float* g2prev, int startv,
                                          LAS int* re_lds  , const LAS float* rwt = nullptr  ) {
    const int b = m >> 11;
    float* X = (float*)(p.ws + WS_X); bf16* H = (bf16*)(p.ws + WS_H);
    f32x4 v[4];
#pragma unroll
    for (int j = 0; j < 4; ++j) v[j] = vin[j];
    if (mode & 1) {
        const unsigned* RS = (const unsigned*)(p.ws + WS_RS); const float* RW = (const float*)(p.ws + WS_RW); const int* RE = (const int*)(p.ws + WS_RE);
        const float w0 = RW[2 * m], w1 = RW[2 * m + 1];
        int p0, p1;
        if (mode & 16) { p0 = shl_from(startv, RE[2 * m]) + (int)RS[2 * m]; p1 = shl_from(startv, RE[2 * m + 1]) + (int)RS[2 * m + 1]; }
        else { p0 = 2 * m; p1 = 2 * m + 1; }
        const bf16* Y = (const bf16*)(p.ws + WS_Y);
#pragma unroll
        for (int j = 0; j < 4; ++j) {
            const u32x2 a = *(const u32x2*)(Y + (size_t)p0 * DM + 256 * j + 4 * lane), c = *(const u32x2*)(Y + (size_t)p1 * DM + 256 * j + 4 * lane);
            const f32x4 g = *(const f32x4*)(g2prev + b * NMOD + 256 * j + 4 * lane);
            v[j].x += g.x * (w0 * lo16(a.x) + w1 * lo16(c.x)); v[j].y += g.y * (w0 * hi16(a.x) + w1 * hi16(c.x));
            v[j].z += g.z * (w0 * lo16(a.y) + w1 * lo16(c.y)); v[j].w += g.w * (w0 * hi16(a.y) + w1 * hi16(c.y));
        }
    }
    if ((mode & 2) && !(mode & 64)) {
#pragma unroll
        for (int j = 0; j < 4; ++j) *(f32x4*)(X + (size_t)m * DM + 256 * j + 4 * lane) = v[j];
    }
    float ss = 0.f;
#pragma unroll
    for (int j = 0; j < 4; ++j) ss += (v[j].x * v[j].x + v[j].y * v[j].y) + (v[j].z * v[j].z + v[j].w * v[j].w);
    ss = wave_sum(ss, lane);
    const float rstd = 1.0f / sqrtf(ss * (1.0f / DM) + EPS);
    if (mode & 4) {
#pragma unroll
        for (int j = 0; j < 4; ++j) { const f32x4 g = *(const f32x4*)(p.fg + 256 * j + 4 * lane); if (!(mode & 64)) *(f32x4*)(p.out + (size_t)m * DM + 256 * j + 4 * lane) = v[j] * rstd * g; }
        return;
    }
    f32x4 h[4];
#pragma unroll
    for (int j = 0; j < 4; ++j) {
        const f32x4 g = *(const f32x4*)(ng + 256 * j + 4 * lane), s1 = *(const f32x4*)(sc + b * NMOD + 256 * j + 4 * lane), s0 = *(const f32x4*)(sh + b * NMOD + 256 * j + 4 * lane);
        h[j] = v[j] * rstd * g * (1.0f + s1) + s0;
        u32x2 o; o.x = pk2(h[j].x, h[j].y); o.y = pk2(h[j].z, h[j].w);
        if (!(mode & 64)) *(u32x2*)(H + (size_t)m * DM + 256 * j + 4 * lane) = o;
    }
    if (mode & 8) {
        float lg[16];
#pragma unroll
        for (int e = 0; e < 16; ++e) lg[e] = 0.f;
#pragma unroll
        for (int j = 0; j < 4; ++j)
#pragma unroll
            for (int e = 0; e < 16; ++e) { const f32x4 r = *(const LAS f32x4*)(rwt + e * 1024 + 256 * j + 4 * lane); lg[e] += (h[j][0] * r[0] + h[j][1] * r[1]) + (h[j][2] * r[2] + h[j][3] * r[3]); }
        {
            const bool b5 = (lane & 32) != 0, b4 = (lane & 16) != 0, b3 = (lane & 8) != 0, b2 = (lane & 4) != 0;
            float v8[8], v4[4], v2[2];
#pragma unroll
            for (int i = 0; i < 8; ++i) { const float mine = b5 ? lg[8 + i] : lg[i], oth = b5 ? lg[i] : lg[8 + i]; v8[i] = mine + shx(oth, 32, lane); }
#pragma unroll
            for (int i = 0; i < 4; ++i) { const float mine = b4 ? v8[4 + i] : v8[i], oth = b4 ? v8[i] : v8[4 + i]; v4[i] = mine + shx(oth, 16, lane); }
#pragma unroll
            for (int i = 0; i < 2; ++i) { const float mine = b3 ? v4[2 + i] : v4[i], oth = b3 ? v4[i] : v4[2 + i]; v2[i] = mine + shx(oth, 8, lane); }
            float v1 = (b2 ? v2[1] : v2[0]) + shx(b2 ? v2[0] : v2[1], 4, lane);
            v1 += shx(v1, 1, lane); v1 += shx(v1, 2, lane);
#pragma unroll
            for (int e = 0; e < 16; ++e) lg[e] = __builtin_bit_cast(float, __builtin_amdgcn_readlane(__builtin_bit_cast(int, v1), 4 * e));
        }
        float scv[16], bi[16];
#pragma unroll
        for (int e = 0; e < 16; ++e) { scv[e] = sigmoidf_(lg[e]); bi[e] = scv[e] + p.rb[e]; }
        float bestg = -1e30f; int e1 = 0, e2 = 1; float w1 = 0.f, w2 = 0.f;
#pragma unroll
        for (int g = 0; g < 4; ++g) {
            float m1 = -1e30f, m2 = -1e30f; int i1 = 0, i2 = 0; float s1 = 0.f, s2 = 0.f;
#pragma unroll
            for (int q = 0; q < 4; ++q) {
                const float vq = bi[4 * g + q];
                if (vq > m1) { m2 = m1; i2 = i1; s2 = s1; m1 = vq; i1 = 4 * g + q; s1 = scv[4 * g + q]; }
                else if (vq > m2) { m2 = vq; i2 = 4 * g + q; s2 = scv[4 * g + q]; }
            }
            const float gs = m1 + m2;
            if (gs > bestg) { bestg = gs; e1 = i1; e2 = i2; w1 = s1; w2 = s2; }
        }
        const float inv = 1.0f / (w1 + w2);
        if (lane == 0 && !(mode & 64)) {
            int* RE = (int*)(p.ws + WS_RE); float* RW = (float*)(p.ws + WS_RW);
            RE[2 * m] = e1; RE[2 * m + 1] = e2; RW[2 * m] = w1 * inv; RW[2 * m + 1] = w2 * inv;
            if (re_lds) { re_lds[0] = e1; re_lds[1] = e2; }
        }
        if (lane == 0 && (mode & 64) && re_lds) { re_lds[0] = e1; re_lds[1] = e2; }
    }
}
__device__ __forceinline__ int expert_start_lane(const unsigned* cnt, int lane) {
    int c = (lane < 16) ? (int)cnt[lane] : 0; c = (c + 255) & ~255;
    int s = c;
#pragma unroll
    for (int o = 1; o < 16; o <<= 1) { const int t = shl_from(s, lane - o); if ((lane & 15) >= o) s += t; }
    return s - c;
}

typedef short bf16x8 __attribute__((ext_vector_type(8)));
typedef short s16x4 __attribute__((ext_vector_type(4)));
typedef float f32x16 __attribute__((ext_vector_type(16)));
typedef __bf16 bf16x2_t __attribute__((ext_vector_type(2)));
typedef float f32x2_t __attribute__((ext_vector_type(2)));
__device__ __forceinline__ unsigned cvtpk(float lo, float hi) { f32x2_t v = {lo, hi}; bf16x2_t b = __builtin_convertvector(v, bf16x2_t); return __builtin_bit_cast(unsigned, b); }
#define MFMA32(a, b, c) __builtin_amdgcn_mfma_f32_32x32x16_bf16((a), (b), (c), 0, 0, 0)
__device__ __forceinline__ int crow(int reg, int h) { return (reg & 3) + 8 * (reg >> 2) + 4 * h; }
template <int S_> __device__ __forceinline__ bf16x8 pack_step(const f32x16& x) {
    u32x4 p; p.x = cvtpk(x[8 * S_], x[8 * S_ + 1]); p.y = cvtpk(x[8 * S_ + 2], x[8 * S_ + 3]); p.z = cvtpk(x[8 * S_ + 4], x[8 * S_ + 5]); p.w = cvtpk(x[8 * S_ + 6], x[8 * S_ + 7]);
    return __builtin_bit_cast(bf16x8, p);
}
__device__ __forceinline__ u32x4 pack8(const f32x4 a, const f32x4 b) { u32x4 w; w.x = cvtpk(a[0], a[1]); w.y = cvtpk(a[2], a[3]); w.z = cvtpk(b[0], b[1]); w.w = cvtpk(b[2], b[3]); return w; }

constexpr int NTHR = 512, NWAVES = 8;
constexpr int RING_BYTES = 135168;
constexpr int LX_OFF = RING_BYTES;
constexpr int LX_BAR = LX_OFF + 0;
constexpr int LX_TS = LX_OFF + 64;
constexpr int LX_CNT = LX_OFF + 192;
constexpr int LX_BASE = LX_OFF + 256;
constexpr int LX_RE = LX_OFF + 320;
constexpr int LX_RANK = LX_OFF + 832;
constexpr int LX_ROWS = LX_OFF + 2048;
constexpr int LDS_BYTES = RING_BYTES + 8192;

constexpr size_t WL_STRIDE = 68 * MiB, WL_IN = 0, WL_PA = 14 * MiB, WL_PB = 16 * MiB, WL_OUT = 18 * MiB, WL_GU = 20 * MiB, WL_D = 52 * MiB;
constexpr int NIN = 6912;
constexpr int T_QA = 0, T_KA = 2, T_GA = 4, T_VA = 6, T_RA = 10, T_QB = 14, T_KV = 18, T_GTA = 19, T_GTB = 23;

#define XB_TMO      128
#define XB_XCNT(j)  (256  + 64 * (j))
#define XB_XSUB(j)  (1280 + 64 * (j))
#define XB_XGEN(j)  (2304 + 64 * (j))
#define XB_TOP      3328
#define XB_TOPGEN   3392
#define XCD_BAR_WORDS 3456
#define XB_SPIN_CAP (1u << 18)
constexpr int CW_BAR = 8192;
__device__ __forceinline__ unsigned xb_ld(unsigned* p)              { return __hip_atomic_load(p, __ATOMIC_RELAXED, __HIP_MEMORY_SCOPE_AGENT); }
__device__ __forceinline__ unsigned xb_add(unsigned* p, unsigned v) { return __hip_atomic_fetch_add(p, v, __ATOMIC_RELAXED, __HIP_MEMORY_SCOPE_AGENT); }
__device__ __forceinline__ unsigned xb_xcc_id() { return (unsigned)__builtin_amdgcn_s_getreg((3 << 11) | 20) & 0xFu; }
#define XB_SPIN(cond, bar) do { unsigned _sp = 0; while (cond) { __builtin_amdgcn_s_sleep(1); \
    if ((++_sp & 255u) == 0u) { if (xb_ld(&(bar)[XB_TMO])) break; if (_sp > XB_SPIN_CAP) { atomicAdd(&(bar)[XB_TMO], 1u); break; } } } } while (0)
struct XcdBarrier { unsigned* bar; unsigned x; volatile LAS unsigned* st; };
__device__ __forceinline__ XcdBarrier xcd_barrier_post(unsigned* bar, volatile LAS unsigned* st) {
    XcdBarrier b; b.bar = bar; b.x = xb_xcc_id(); b.st = st;
    if (threadIdx.x == 0) (void)xb_add(&bar[XB_XCNT(b.x)], 1u);
    return b;
}
__device__ __forceinline__ void xcd_barrier_complete(unsigned* bar, unsigned x, unsigned& nloc, unsigned& nx) {
    const unsigned G = gridDim.x * gridDim.y * gridDim.z;
    unsigned sum, cnt, mine, sp = 0u;
    for (;;) {
        sum = 0u; cnt = 0u; mine = 0u;
#pragma unroll
        for (unsigned j = 0; j < 16; ++j) { const unsigned c = xb_ld(&bar[XB_XCNT(j)]); sum += c; cnt += (c > 0u) ? 1u : 0u; mine = (j == x) ? c : mine; }
        if (sum == G) break;
        __builtin_amdgcn_s_sleep(1);
        if ((++sp & 255u) == 0u) { if (xb_ld(&bar[XB_TMO])) break; if (sp > XB_SPIN_CAP) { atomicAdd(&bar[XB_TMO], 1u); break; } }
    }
    nloc = mine > 0u ? mine : 1u; nx = cnt > 0u ? cnt : 1u;
}
__device__ __forceinline__ void xcd_barrier(const XcdBarrier& b) {
    asm volatile("s_waitcnt vmcnt(0)" ::: "memory");
    __syncthreads();
    if (threadIdx.x == 0) {
        unsigned* bar = b.bar;
        __builtin_amdgcn_s_waitcnt(0);
        unsigned nloc = b.st[0], nx = b.st[1];
        if (nloc == 0u) { xcd_barrier_complete(bar, b.x, nloc, nx); b.st[0] = nloc; b.st[1] = nx; }
        const unsigned old = xb_add(&bar[XB_XSUB(b.x)], 1u);
        const unsigned gen = old / nloc;
        if (old + 1u == (gen + 1u) * nloc) {
            __builtin_amdgcn_fence(__ATOMIC_RELEASE, "agent");
            asm volatile("s_waitcnt vmcnt(0)" ::: "memory");
            const unsigned og = xb_add(&bar[XB_TOP], 1u);
            const unsigned tg = og / nx;
            if (og + 1u == (tg + 1u) * nx) xb_add(&bar[XB_TOPGEN], 1u);
            else XB_SPIN(xb_ld(&bar[XB_TOPGEN]) == tg, bar);
            __builtin_amdgcn_fence(__ATOMIC_ACQUIRE, "agent");
            xb_add(&bar[XB_XGEN(b.x)], 1u);
            asm volatile("s_waitcnt vmcnt(0)" ::: "memory");
        } else {
            XB_SPIN(xb_ld(&bar[XB_XGEN(b.x)]) == gen, bar);
            __builtin_amdgcn_fence(__ATOMIC_ACQUIRE, "agent");
            asm volatile("s_waitcnt vmcnt(0)" ::: "memory");
        }
    }
    __syncthreads();
}

namespace pg8 {
constexpr int BM = 256, BK = 64, HALF = 128, HTB = HALF * BK * 2, STAGE_BYTES = 8 * HTB, NXCD = 8, WGM = 8;
__device__ __forceinline__ int lds_byte(int r, int c) { const int st = (r >> 4) * 2 + (c >> 5), rr = r & 15, cc = c & 31, ob = rr * 64 + cc * 2; return st * 1024 + (ob ^ (((ob >> 9) & 1) << 5)); }
__device__ __forceinline__ void stage_rc(int b, int& R, int& C) { const int st = b / 1024, sb = b % 1024, swz = sb ^ (((sb >> 9) & 1) << 5); R = (st >> 1) * 16 + swz / 64; C = (st & 1) * 32 + (swz % 64) / 2; }
__device__ __forceinline__ int perm32(int rho) { const int n = rho >> 4, i = rho & 15; return 8 * (i >> 2) + 4 * n + (i & 3); }
struct Unit { int pm, pn, z, e; const char* a; const char* b; };

template <class Epi, class Sched, bool GATHER>
__device__ __forceinline__ void gemm_phase(LAS unsigned char* lds, const int tid, const int K, const Sched& S, const Epi& E) {
    const int wid = __builtin_amdgcn_readfirstlane(tid >> 6), lane = tid & 63, wr = wid >> 2, wc = wid & 3, fr = lane & 15, fq = lane >> 4;
    const int nt = K / BK;
    unsigned voffA[2], voffB[2];
#pragma unroll
    for (int i = 0; i < 2; ++i) { int R, C; stage_rc(tid * 16 + i * 8192, R, C); const int Rb = Epi::PERM ? ((R & ~31) + perm32(R & 31)) : R;
        voffA[i] = (unsigned)(R * K + C) * 2u; voffB[i] = (unsigned)(Rb * K + C) * 2u; }
    unsigned gA[2][2], gN[2][2];
    const size_t kstep = (size_t)(BK * 2);
    const size_t hstep = (size_t)HALF * K * 2;
    const unsigned ldsw = (unsigned)wid * 1024u;
    const int aoff = lds_byte(wr * 64 + fr, fq * 8), boff = lds_byte(wc * 32 + fr, fq * 8);
#define PG8_SA(b, h) (((b) * 2 + (h)) * HTB)
#define PG8_SB(b, h) ((4 + (b) * 2 + (h)) * HTB)
#define PG8_STAGE_B(bufoff, gbase) do { _Pragma("unroll") for (int _i = 0; _i < 2; ++_i) \
        __builtin_amdgcn_global_load_lds((const unsigned*)((const char*)(gbase) + voffB[_i]), (LAS unsigned*)(lds + (bufoff) + ldsw + _i * 8192), 16, 0, 0); } while (0)
#define PG8_STAGE_A(bufoff, gbase, h, G) do { _Pragma("unroll") for (int _i = 0; _i < 2; ++_i) { \
        const char* _p = GATHER ? ((const char*)(gbase) + G[h][_i]) : ((const char*)(gbase) + (size_t)(h) * hstep + voffA[_i]); \
        __builtin_amdgcn_global_load_lds((const unsigned*)_p, (LAS unsigned*)(lds + (bufoff) + ldsw + _i * 8192), 16, 0, 0); } } while (0)
#define PG8_LDA(dst, b, h) do { _Pragma("unroll") for (int m = 0; m < 4; ++m) _Pragma("unroll") for (int k = 0; k < 2; ++k) dst[m][k] = *(const LAS bf16x8*)(lds + PG8_SA(b, h) + aoff + m * 2048 + k * 1024); } while (0)
#define PG8_LDB(dst, b, h) do { _Pragma("unroll") for (int n = 0; n < 2; ++n) _Pragma("unroll") for (int k = 0; k < 2; ++k) dst[n][k] = *(const LAS bf16x8*)(lds + PG8_SB(b, h) + boff + n * 2048 + k * 1024); } while (0)
#define PG8_MMA(ai, bj, At, Bt) do { __builtin_amdgcn_s_setprio(1); _Pragma("unroll") for (int m = 0; m < 4; ++m) _Pragma("unroll") for (int n = 0; n < 2; ++n) _Pragma("unroll") for (int k = 0; k < 2; ++k) \
        acc[ai][bj][m][n] = __builtin_amdgcn_mfma_f32_16x16x32_bf16(Bt[n][k], At[m][k], acc[ai][bj][m][n], 0, 0, 0); __builtin_amdgcn_s_setprio(0); } while (0)
#define PG8_WAIT_V(n) asm volatile("s_waitcnt vmcnt(" #n ")" ::: "memory")
#define PG8_WAIT_L(n) asm volatile("s_waitcnt lgkmcnt(" #n ")" ::: "memory")
#define PG8_BAR __builtin_amdgcn_s_barrier()
#define PG8_SCHED __builtin_amdgcn_sched_barrier(0)
    Unit cur, nxt; int ui = 0;
    if (!S.next(0, cur)) return;
    f32x4 acc[2][2][4][2];
#pragma unroll
    for (int a = 0; a < 2; ++a)
#pragma unroll
        for (int b = 0; b < 2; ++b)
#pragma unroll
            for (int m = 0; m < 4; ++m)
#pragma unroll
                for (int n = 0; n < 2; ++n) acc[a][b][m][n] = (f32x4){0.f, 0.f, 0.f, 0.f};
    bf16x8 At[4][2], B0[2][2], B1[2][2];
    if constexpr (GATHER) S.rows(0, K, tid, gA);
    const char* cA = cur.a; const char* cB = cur.b;
    PG8_STAGE_B(PG8_SB(0, 0), cB); PG8_STAGE_B(PG8_SB(0, 1), cB + hstep); PG8_STAGE_A(PG8_SA(0, 0), cA, 0, gA); PG8_STAGE_A(PG8_SA(0, 1), cA, 1, gA);
    if (wr == 1) PG8_BAR;
    PG8_WAIT_V(2); PG8_BAR;
    PG8_STAGE_B(PG8_SB(1, 0), cB + kstep); PG8_STAGE_A(PG8_SA(1, 0), cA + kstep, 0, gA); PG8_STAGE_B(PG8_SB(1, 1), cB + hstep + kstep);
    PG8_WAIT_V(6); PG8_BAR;
    for (;;) {
        const bool has_next = S.next(ui + 1, nxt);
        const char* nA = has_next ? nxt.a : cA; const char* nB = has_next ? nxt.b : cB;
        if constexpr (GATHER) { if (has_next) S.rows(ui + 1, K, tid, gN); else { gN[0][0] = gA[0][0]; gN[0][1] = gA[0][1]; gN[1][0] = gA[1][0]; gN[1][1] = gA[1][1]; } }
        for (int t = 0; t < nt; t += 2) {
            const bool last = (t == nt - 2);
            const char* a1 = cA + (size_t)(t + 1) * kstep;
            const char* a2 = last ? nA : cA + (size_t)(t + 2) * kstep; const char* b2 = last ? nB : cB + (size_t)(t + 2) * kstep;
            const char* a3 = a2 + kstep; const char* b3 = b2 + kstep;
            unsigned g2[2][2];
            if constexpr (GATHER) { g2[0][0] = last ? gN[0][0] : gA[0][0]; g2[0][1] = last ? gN[0][1] : gA[0][1]; g2[1][0] = last ? gN[1][0] : gA[1][0]; g2[1][1] = last ? gN[1][1] : gA[1][1]; }
            PG8_LDB(B0, 0, 0); PG8_LDB(B1, 0, 1); PG8_SCHED; PG8_LDA(At, 0, 0); PG8_STAGE_A(PG8_SA(1, 1), a1, 1, gA);
            PG8_WAIT_V(8); PG8_WAIT_L(0); PG8_BAR; PG8_MMA(0, 0, At, B0); PG8_MMA(0, 1, At, B1); PG8_BAR; PG8_SCHED;
            PG8_LDA(At, 0, 1); PG8_STAGE_B(PG8_SB(0, 0), b2); PG8_STAGE_B(PG8_SB(0, 1), b2 + hstep); PG8_STAGE_A(PG8_SA(0, 0), a2, 0, g2);
            PG8_WAIT_V(8); PG8_WAIT_L(0); PG8_BAR; PG8_MMA(1, 0, At, B0); PG8_MMA(1, 1, At, B1); PG8_BAR; PG8_SCHED;
            PG8_LDB(B0, 1, 0); PG8_LDB(B1, 1, 1); PG8_SCHED; PG8_LDA(At, 1, 0); PG8_STAGE_A(PG8_SA(0, 1), a2, 1, g2);
            PG8_WAIT_V(8); PG8_WAIT_L(0); PG8_BAR; PG8_MMA(0, 0, At, B0); PG8_MMA(0, 1, At, B1); PG8_BAR; PG8_SCHED;
            PG8_LDA(At, 1, 1); PG8_STAGE_B(PG8_SB(1, 0), b3); PG8_STAGE_B(PG8_SB(1, 1), b3 + hstep); PG8_STAGE_A(PG8_SA(1, 0), a3, 0, g2);
            PG8_WAIT_V(8); PG8_WAIT_L(0); PG8_BAR; PG8_MMA(1, 0, At, B0); PG8_MMA(1, 1, At, B1); PG8_BAR; PG8_SCHED;
        }
        if (wr == 0) PG8_BAR;
        E(acc, cur, wr, wc, fr, fq);
        if (!has_next) break;
        if (!(Epi::CHAIN && cur.z == 0))
#pragma unroll
        for (int a = 0; a < 2; ++a)
#pragma unroll
            for (int b = 0; b < 2; ++b)
#pragma unroll
                for (int m = 0; m < 4; ++m)
#pragma unroll
                    for (int n = 0; n < 2; ++n) acc[a][b][m][n] = (f32x4){0.f, 0.f, 0.f, 0.f};
        cur = nxt; cA = nA; cB = nB; ++ui;
        if constexpr (GATHER) { gA[0][0] = gN[0][0]; gA[0][1] = gN[0][1]; gA[1][0] = gN[1][0]; gA[1][1] = gN[1][1]; }
        if (wr == 1) PG8_BAR;
    }
    PG8_WAIT_V(0);
    PG8_BAR;
#undef PG8_SA
#undef PG8_SB
#undef PG8_STAGE_A
#undef PG8_STAGE_B
#undef PG8_LDA
#undef PG8_LDB
#undef PG8_MMA
#undef PG8_WAIT_V
#undef PG8_WAIT_L
#undef PG8_BAR
#undef PG8_SCHED
}

__device__ __forceinline__ bool static_tile(int L, int nM, int nN, int& pm, int& pn) {
    const int nwg = nM * nN; if (L >= nwg) return false;
    int wgid = L; { const int q = nwg / NXCD, r = nwg % NXCD, xcd = wgid % NXCD, off = wgid / NXCD; wgid = (xcd < r ? xcd * (q + 1) : r * (q + 1) + (xcd - r) * q) + off; }
    const int nig = WGM * nN, gid = wgid / nig, fm = gid * WGM, gsz = (nM - fm) < WGM ? (nM - fm) : WGM;
    pm = fm + ((wgid % nig) % gsz); pn = (wgid % nig) / gsz; return true;
}
struct SchedStatic {
    int nM, nN, G, c; const char* A; const char* B; size_t ta, tb;
    __device__ __forceinline__ bool next(int i, Unit& u) const {
        int pm, pn; if (!static_tile(i * G + c, nM, nN, pm, pn)) return false;
        u.pm = pm; u.pn = pn; u.z = 0; u.e = 0; u.a = A + (size_t)pm * ta; u.b = B + (size_t)pn * tb; return true; }
};
struct SchedPair {
    int nM, nN, G, c; const char* A0; const char* B0; const char* A1; const char* B1; size_t ta, tb;
    __device__ __forceinline__ bool next(int i, Unit& u) const {
        int pm, pn; if (!static_tile((i >> 1) * G + c, nM, nN, pm, pn)) return false;
        u.pm = pm; u.pn = pn; u.z = i & 1; u.e = 0; u.a = ((i & 1) ? A1 : A0) + (size_t)pm * ta; u.b = ((i & 1) ? B1 : B0) + (size_t)pn * tb; return true; }
};
struct SchedMoe {
    int G, c; const LAS int* ts; const LAS unsigned* rowtab; const char* A; const char* B; size_t ta, tbe, tbt;
    __device__ __forceinline__ bool next(int i, Unit& u) const {
        const int L = i * G + c; if (L >= 4 * ts[16]) return false;
        const int rt = L >> 2, pn = L & 3; int e = 0;
#pragma unroll
        for (int q = 1; q < 16; ++q) e += (rt >= ts[q]) ? 1 : 0;
        u.pm = rt; u.pn = pn; u.z = 0; u.e = e; u.a = A + (size_t)rt * ta; u.b = B + (size_t)e * tbe + (size_t)pn * tbt; return true; }
    __device__ __forceinline__ void rows(int i, int K, int tid, unsigned (&g)[2][2]) const {
#pragma unroll
        for (int p = 0; p < 2; ++p) { int R, C; stage_rc(tid * 16 + p * 8192, R, C);
            g[0][p] = rowtab[i * 256 + R] + (unsigned)C * 2u; g[1][p] = rowtab[i * 256 + 128 + R] + (unsigned)C * 2u; }
    }
};
}
using pg8::Unit;
__device__ __forceinline__ f32x4 silu4(f32x4 v) { f32x4 r; r[0] = siluf_(v[0]); r[1] = siluf_(v[1]); r[2] = siluf_(v[2]); r[3] = siluf_(v[3]); return r; }
__device__ __forceinline__ f32x4 sigm4(f32x4 v) { f32x4 r; r[0] = sigmoidf_(v[0]); r[1] = sigmoidf_(v[1]); r[2] = sigmoidf_(v[2]); r[3] = sigmoidf_(v[3]); return r; }
__device__ __forceinline__ f32x4 bflo4(u32x2 w) { return (f32x4){lo16(w.x), hi16(w.x), lo16(w.y), hi16(w.y)}; }

#ifndef EPI_NT
#define EPI_NT 1
#endif
#if EPI_NT
#define EPI_ST16(p_, v_) __builtin_nontemporal_store((v_), (u32x4*)(p_))
#define EPI_ST16F(p_, v_) __builtin_nontemporal_store((v_), (f32x4*)(p_))
#else
#define EPI_ST16(p_, v_) (*(u32x4*)(p_) = (v_))
#define EPI_ST16F(p_, v_) (*(f32x4*)(p_) = (v_))
#endif
struct EpiInProj {
    static constexpr bool PERM = true, CHAIN = false;
    unsigned char* ws; const float* ab; bool skip, nost;
    template <int KIND> __device__ __forceinline__ void run(const f32x4 (&acc)[2][2][4][2], const Unit& u, int wr, int wc, int fr, int fq) const {
        const int pn = u.pn;
#pragma unroll
        for (int ai = 0; ai < 2; ++ai)
#pragma unroll
            for (int m = 0; m < 4; ++m) {
                const int row = u.pm * 256 + ai * 128 + wr * 64 + m * 16 + fr, b = row >> 11, s = row & 2047;
#pragma unroll
                for (int bj = 0; bj < 2; ++bj) {
                    const int c8 = bj * 128 + wc * 32 + 8 * fq;
                    const f32x4 v0 = acc[ai][bj][m][0], v1 = acc[ai][bj][m][1];
                    if (KIND == 0) {
                        const int cc = (pn & 1) * 256 + c8, h = cc >> 7, d = cc & 127;
                        bf16* dst = (bf16*)(ws + (pn < T_KA ? WS_QA : WS_KA)) + ((size_t)(b * 4 + h) * SEQ + s) * 128 + d;
                        if (!nost) EPI_ST16(dst, pack8(v0, v1));
                    } else if (KIND == 1) {
                        const int cc = (pn - T_GA) * 256 + c8, h = cc >> 7, d = cc & 127;
                        const f32x4 b0 = *(const f32x4*)(ab + cc), b1 = *(const f32x4*)(ab + cc + 4);
                        f32x4 g0, g1;
#pragma unroll
                        for (int q = 0; q < 4; ++q) { const float x0 = v0[q] + b0[q], x1 = v1[q] + b1[q];
                            g0[q] = (fminf(x0, 0.f) - __logf(1.0f + __expf(-fabsf(x0)))) * 0.0625f; g1[q] = (fminf(x1, 0.f) - __logf(1.0f + __expf(-fabsf(x1)))) * 0.0625f; }
                        float* dst = (float*)(ws + WS_GA) + ((size_t)(b * 4 + h) * SEQ + s) * 128 + d;
                        if (!nost) { EPI_ST16F(dst, g0); EPI_ST16F(dst + 4, g1); }
                    } else if (KIND == 2) {
                        const int h = pn - T_VA;
                        bf16* dst = (bf16*)(ws + WS_VA) + ((size_t)(b * 4 + h) * SEQ + s) * 256 + c8;
                        if (!nost) EPI_ST16(dst, pack8(v0, v1));
                    } else if (KIND == 3) {
                        bf16* dst = (bf16*)(ws + WS_RA) + (size_t)row * 1024 + (pn - T_RA) * 256 + c8;
                        if (!nost) EPI_ST16(dst, pack8(silu4(v0), silu4(v1)));
                    } else if (KIND == 4) {
                        if (pn == T_KV && bj == 1) {
                            bf16* dst = (bf16*)(ws + WS_VB) + (size_t)row * 128 + (c8 - 128);
                            if (!nost) EPI_ST16(dst, pack8(v0, v1));
                        } else {
                            const int j0 = (c8 & 63) >> 1;
                            const f32x4* tab = (const f32x4*)((const float2*)(ws + WS_ROPE) + (size_t)row * 32 + j0);
                            const f32x4 t0 = tab[0], t1 = tab[1];
                            const float sc = (pn == T_KV) ? 1.0f : 0.125f;
                            f32x4 o0, o1;
                            o0[0] = (v0[0] * t0[0] - v0[1] * t0[1]) * sc; o0[1] = (v0[1] * t0[0] + v0[0] * t0[1]) * sc;
                            o0[2] = (v0[2] * t0[2] - v0[3] * t0[3]) * sc; o0[3] = (v0[3] * t0[2] + v0[2] * t0[3]) * sc;
                            o1[0] = (v1[0] * t1[0] - v1[1] * t1[1]) * sc; o1[1] = (v1[1] * t1[0] + v1[0] * t1[1]) * sc;
                            o1[2] = (v1[2] * t1[2] - v1[3] * t1[3]) * sc; o1[3] = (v1[3] * t1[2] + v1[2] * t1[3]) * sc;
                            bf16* dst = (pn == T_KV) ? (bf16*)(ws + WS_KB) + (size_t)row * 128 + c8 : (bf16*)(ws + WS_QB) + (size_t)row * 1024 + (pn - T_QB) * 256 + c8;
                            if (!nost) EPI_ST16(dst, pack8(o0, o1));
                        }
                    } else {
                        bf16* dst = (pn < T_GTB) ? (bf16*)(ws + WS_GTA) + (size_t)row * 1024 + (pn - T_GTA) * 256 + c8 : (bf16*)(ws + WS_GTB) + (size_t)row * 1024 + (pn - T_GTB) * 256 + c8;
                        if (!nost) EPI_ST16(dst, pack8(sigm4(v0), sigm4(v1)));
                    }
                }
                asm volatile("" ::: "memory");
            }
    }
    __device__ __forceinline__ void operator()(const f32x4 (&acc)[2][2][4][2], const Unit& u, int wr, int wc, int fr, int fq) const {
        const int pn = u.pn;
        if (skip) return;
        if (pn < T_GA) run<0>(acc, u, wr, wc, fr, fq);
        else if (pn < T_VA) run<1>(acc, u, wr, wc, fr, fq);
        else if (pn < T_RA) run<2>(acc, u, wr, wc, fr, fq);
        else if (pn < T_QB) run<3>(acc, u, wr, wc, fr, fq);
        else if (pn < T_GTA) run<4>(acc, u, wr, wc, fr, fq);
        else run<5>(acc, u, wr, wc, fr, fq);
    }
};
struct EpiMerge {
    static constexpr bool PERM = true, CHAIN = true;
    unsigned char* ws;
    __device__ __forceinline__ void operator()(f32x4 (&acc)[2][2][4][2], const Unit& u, int wr, int wc, int fr, int fq) const {
#pragma unroll
        for (int ai = 0; ai < 2; ++ai)
#pragma unroll
            for (int m = 0; m < 4; ++m) {
                const int row = u.pm * 256 + ai * 128 + wr * 64 + m * 16 + fr;
#pragma unroll
                for (int bj = 0; bj < 2; ++bj) {
                    const size_t off = (size_t)row * 1024 + u.pn * 256 + bj * 128 + wc * 32 + 8 * fq;
                    const u32x4 gb = *(const u32x4*)((const bf16*)(ws + WS_GTB) + off);
                    f32x4 b0 = bflo4((u32x2){gb.x, gb.y}), b1 = bflo4((u32x2){gb.z, gb.w});
#pragma unroll
                    for (int q = 0; q < 4; ++q) { b0[q] = fmaxf(b0[q], 1e-20f); b1[q] = fmaxf(b1[q], 1e-20f); }
                    if (u.z == 0) {
                        const u32x4 ga = *(const u32x4*)((const bf16*)(ws + WS_GTA) + off);
                        const f32x4 a0 = bflo4((u32x2){ga.x, ga.y}), a1 = bflo4((u32x2){ga.z, ga.w});
#pragma unroll
                        for (int q = 0; q < 4; ++q) { acc[ai][bj][m][0][q] *= a0[q] * __builtin_amdgcn_rcpf(b0[q]); acc[ai][bj][m][1][q] *= a1[q] * __builtin_amdgcn_rcpf(b1[q]); }
                    } else {
                        *(u32x4*)((bf16*)(ws + WS_H) + off) = pack8(acc[ai][bj][m][0] * b0, acc[ai][bj][m][1] * b1);
                    }
                }
            }
    }
};
struct EpiResid {
    static constexpr bool PERM = false, CHAIN = false;
    float* X; const float* g1; bool st;
    __device__ __forceinline__ void operator()(const f32x4 (&acc)[2][2][4][2], const Unit& u, int wr, int wc, int fr, int fq) const {
#pragma unroll
        for (int ai = 0; ai < 2; ++ai)
#pragma unroll
            for (int m = 0; m < 4; ++m) {
                const int row = u.pm * 256 + ai * 128 + wr * 64 + m * 16 + fr, b = row >> 11;
#pragma unroll
                for (int bj = 0; bj < 2; ++bj)
#pragma unroll
                    for (int n = 0; n < 2; ++n) {
                        const int col = u.pn * 256 + bj * 128 + wc * 32 + n * 16 + 4 * fq;
                        float* xp = X + (size_t)row * 1024 + col;
                        const f32x4 g = *(const f32x4*)(g1 + b * NMOD + col);
                        const f32x4 nv = *(const f32x4*)xp + g * acc[ai][bj][m][n]; if (st) *(f32x4*)xp = nv;
                    }
            }
    }
};
struct EpiMoeUp {
    static constexpr bool PERM = true, CHAIN = false;
    bf16* HID;
    __device__ __forceinline__ void operator()(const f32x4 (&acc)[2][2][4][2], const Unit& u, int wr, int wc, int fr, int fq) const {
#pragma unroll
        for (int ai = 0; ai < 2; ++ai)
#pragma unroll
            for (int m = 0; m < 4; ++m) {
                const int row = u.pm * 256 + ai * 128 + wr * 64 + m * 16 + fr;
#pragma unroll
                for (int bj = 0; bj < 2; ++bj) {
                    const int f = (u.pn * 256 + bj * 128 + wc * 32 + 8 * fq) >> 1;
                    const f32x4 hv = silu4(acc[ai][bj][m][0]) * acc[ai][bj][m][1];
                    u32x2 w; w.x = cvtpk(hv[0], hv[1]); w.y = cvtpk(hv[2], hv[3]);
                    *(u32x2*)(HID + (size_t)row * 512 + f) = w;
                }
            }
    }
};
struct EpiMoeDown {
    static constexpr bool PERM = true, CHAIN = false;
    bf16* Y;
    __device__ __forceinline__ void operator()(const f32x4 (&acc)[2][2][4][2], const Unit& u, int wr, int wc, int fr, int fq) const {
#pragma unroll
        for (int ai = 0; ai < 2; ++ai)
#pragma unroll
            for (int m = 0; m < 4; ++m) {
                const int row = u.pm * 256 + ai * 128 + wr * 64 + m * 16 + fr;
#pragma unroll
                for (int bj = 0; bj < 2; ++bj)
                    *(u32x4*)(Y + (size_t)row * 1024 + u.pn * 256 + bj * 128 + wc * 32 + 8 * fq) = pack8(acc[ai][bj][m][0], acc[ai][bj][m][1]);
            }
    }
};
#define VM_WAIT() asm volatile("s_waitcnt vmcnt(0)" ::: "memory")
#define LDS_WAIT() asm volatile("s_waitcnt lgkmcnt(0)" ::: "memory")

__device__ __forceinline__ void conv_item(const float* cp, int ldw, bool fold, const float* aw_col, int Kdst, bf16* WT, int n0, int k0, LAS float* scr, int lane) {
    float v[32];
    if (!fold) {
#pragma unroll
        for (int i = 0; i < 32; ++i) v[i] = cp[(size_t)(k0 + 2 * i + (lane >> 5)) * ldw];
    } else {
        float aw[16];
#pragma unroll
        for (int r = 0; r < 16; ++r) aw[r] = aw_col[r * 512];
#pragma unroll
        for (int i = 0; i < 32; ++i) { const f32x4* lr = (const f32x4*)(cp + (size_t)(k0 + 2 * i + (lane >> 5)) * ldw); float a = 0.f;
#pragma unroll
            for (int q = 0; q < 4; ++q) { const f32x4 t = lr[q]; a += t[0] * aw[4 * q] + t[1] * aw[4 * q + 1] + t[2] * aw[4 * q + 2] + t[3] * aw[4 * q + 3]; }
            v[i] = a; }
    }
#pragma unroll
    for (int i = 0; i < 32; ++i) scr[(2 * i + (lane >> 5)) * 33 + (lane & 31)] = v[i];
    LDS_WAIT(); asm volatile("" ::: "memory");
    const int c = lane & 7;
#pragma unroll
    for (int j = 0; j < 4; ++j) { const int n = (lane >> 3) + 8 * j; const LAS float* s = scr + (8 * c) * 33 + n;
        u32x4 o; o.x = cvtpk(s[0 * 33], s[1 * 33]); o.y = cvtpk(s[2 * 33], s[3 * 33]); o.z = cvtpk(s[4 * 33], s[5 * 33]); o.w = cvtpk(s[6 * 33], s[7 * 33]);
        *(u32x4*)(WT + (size_t)(n0 + n) * Kdst + k0 + 8 * c) = o; }
    LDS_WAIT(); asm volatile("" ::: "memory");
}
constexpr int IT_IN = 16 * 216, IT_SQ = 16 * 32, IT_GU = 16 * 512, IT_D = 16 * 256, IT_LAYER = IT_IN + 3 * IT_SQ + IT_GU + IT_D;
__device__ __forceinline__ void conv_layer_item(const P& p, int l, int r, LAS float* scr, int lane) {
    {
        const int nl = lane & 31;
        unsigned char* wl = p.ws + WS_W + (size_t)l * WL_STRIDE;
        if (r < IT_IN) {
            const int kb = r / 216, nb = r % 216, n0 = 32 * nb, np = n0 + nl; const float* W = p.w_in + (size_t)l * 1024 * DIN;
            int col; bool fold = false;
            if (np < 512) col = C_QA + np; else if (np < 1024) col = C_KA + np - 512; else if (np < 1536) { fold = true; col = C_LR; }
            else if (np < 2560) col = C_VA + np - 1536; else if (np < 3584) col = C_RA + np - 2560;
            else if (np < 4608) { const int q = np - 3584, pp = q & 63; col = C_QB + (q >> 6) * 64 + (pp >> 1) + 32 * (pp & 1); }
            else if (np < 4736) { const int q = np - 4608, pp = q & 63; col = C_KB + (q >> 6) * 64 + (pp >> 1) + 32 * (pp & 1); }
            else if (np < 4864) col = C_VB + np - 4736; else if (np < 5888) col = C_GTA + np - 4864; else col = C_GTB + np - 5888;
            conv_item(W + col, DIN, fold, p.aw + (size_t)l * 16 * 512 + (np - 1024), 1024, (bf16*)(wl + WL_IN), n0, 64 * kb, scr, lane);
            return;
        }
        r -= IT_IN;
        if (r < 3 * IT_SQ) {
            const int which = r / IT_SQ, rr = r % IT_SQ, kb = rr / 32, nb = rr % 32;
            const float* wsel0 = p.w_pa; const float* wsel1 = p.w_pb; const float* wsel2 = p.w_out;
            asm volatile("" : "+s"(wsel0), "+s"(wsel1), "+s"(wsel2));
            const float* W = (which == 0 ? wsel0 : which == 1 ? wsel1 : wsel2) + (size_t)l * 1024 * 1024;
            conv_item(W + 32 * nb + nl, 1024, false, nullptr, 1024, (bf16*)(wl + (which == 0 ? WL_PA : which == 1 ? WL_PB : WL_OUT)), 32 * nb, 64 * kb, scr, lane);
            return;
        }
        r -= 3 * IT_SQ;
        if (r < IT_GU) {
            const int e = r / 512, rr = r % 512, kb = rr / 32, nb = rr % 32, np = 32 * nb + nl, f = 4 * (np >> 3) + (np & 3);
            const float* gsel0 = p.wg; const float* gsel1 = p.wu; asm volatile("" : "+s"(gsel0), "+s"(gsel1));
            const float* W = ((np & 4) ? gsel1 : gsel0) + ((size_t)l * NE + e) * 1024 * 512;
            conv_item(W + f, 512, false, nullptr, 1024, (bf16*)(wl + WL_GU) + (size_t)e * 1024 * 1024, 32 * nb, 64 * kb, scr, lane);
            return;
        }
        r -= IT_GU;
        { const int e = r / 256, rr = r % 256, kb = rr / 32, nb = rr % 32;
          const float* W = p.wd + ((size_t)l * NE + e) * 512 * 1024;
          conv_item(W + 32 * nb + nl, 1024, false, nullptr, 512, (bf16*)(wl + WL_D) + (size_t)e * 1024 * 512, 32 * nb, 64 * kb, scr, lane); }
    }
}
__device__ __forceinline__ void conv_layer_static(const P& p, int l, LAS unsigned char* lds, int gw, int ngw, int wave, int lane) {
    LAS float* scr = (LAS float*)(lds + wave * 16384);
    for (int r = gw; r < IT_LAYER; r += ngw) conv_layer_item(p, l, r, scr, lane);
}
#ifndef CONV_OVERLAP
#define CONV_OVERLAP 0
#endif
constexpr int CONV_CHUNK = 4, CW_CONV = 2048;
__device__ __forceinline__ void conv_layer_dynamic(const P& p, int l, LAS unsigned char* lds, int wave, int lane, int nchunks) {
    LAS float* scr = (LAS float*)(lds + wave * 16384);
    unsigned* cnt = (unsigned*)(p.ws + WS_CTL) + CW_CONV + 64 * l;
    for (int ch = 0; nchunks < 0 || ch < nchunks; ++ch) {
        unsigned r0 = 0; if (lane == 0) r0 = __hip_atomic_fetch_add(cnt, (unsigned)CONV_CHUNK, __ATOMIC_RELAXED, __HIP_MEMORY_SCOPE_AGENT);
        r0 = (unsigned)__builtin_amdgcn_readfirstlane((int)r0);
        if (r0 >= (unsigned)IT_LAYER) break;
        for (int q = 0; q < CONV_CHUNK; ++q) conv_layer_item(p, l, (int)r0 + q, scr, lane);
    }
}
__device__ __forceinline__ void prologue_mod(const P& p, LAS unsigned char* lds, int bid, int nb, int tid) {
    LAS float* cond = (LAS float*)lds; LAS float* part = (LAS float*)(lds + 32768);
    const int lane = tid & 63, w = tid >> 6;
    for (int i = tid; i < 8192; i += NTHR) cond[i] = siluf_(p.c[i]);
    __syncthreads();
    for (int u = bid; u < NL * NMOD / 64; u += nb) {
        const int l = u / (NMOD / 64), j = (u % (NMOD / 64)) * 64 + lane;
        float a0 = 0, a1 = 0, a2 = 0, a3 = 0, a4 = 0, a5 = 0, a6 = 0, a7 = 0;
        const float* wp = p.ada_w + ((size_t)l * 1024 + 128 * w) * NMOD + j; const LAS float* cw = cond + 128 * w;
#pragma unroll 16
        for (int k = 0; k < 128; ++k) {
            const float wv = wp[(size_t)k * NMOD];
            a0 += cw[k] * wv; a1 += cw[1024 + k] * wv; a2 += cw[2048 + k] * wv; a3 += cw[3072 + k] * wv;
            a4 += cw[4096 + k] * wv; a5 += cw[5120 + k] * wv; a6 += cw[6144 + k] * wv; a7 += cw[7168 + k] * wv;
        }
        LAS float* pw = part + w * 512 + lane;
        pw[0] = a0; pw[64] = a1; pw[128] = a2; pw[192] = a3; pw[256] = a4; pw[320] = a5; pw[384] = a6; pw[448] = a7;
        LDS_WAIT(); __syncthreads();
        {
            float sacc = p.ada_b[l * NMOD + j];
#pragma unroll
            for (int q = 0; q < 8; ++q) sacc += part[q * 512 + w * 64 + lane];
            ((float*)(p.ws + WS_MOD))[((size_t)l * 8 + w) * NMOD + j] = sacc;
        }
        __syncthreads();
    }
    __syncthreads();
}

constexpr int G1_TOT = 0, G1_QE = 2048, G1_KI = 2048 + 17408, G1_VT = 2048 + 2 * 17408;
struct G1In { float g[16]; unsigned short q[16], k[16]; u32x4 v[4]; };
__device__ __forceinline__ void gla1_zero(G1In& in) {
#pragma unroll
    for (int i = 0; i < 16; ++i) { in.g[i] = 0.f; in.q[i] = 0; in.k[i] = 0; }
#pragma unroll
    for (int i = 0; i < 4; ++i) in.v[i] = (u32x4){0u, 0u, 0u, 0u};
}
__device__ __forceinline__ void gla1_load(const P& p, int item, int tid, G1In& in) {
    const int bh = item >> 5, c = item & 31;
    const bf16* Qg = (const bf16*)(p.ws + WS_QA) + ((size_t)bh * SEQ + 64 * c) * 128;
    const bf16* Kg = (const bf16*)(p.ws + WS_KA) + ((size_t)bh * SEQ + 64 * c) * 128;
    const float* Gg = (const float*)(p.ws + WS_GA) + ((size_t)bh * SEQ + 64 * c) * 128;
    const bf16* Vg = (const bf16*)(p.ws + WS_VA) + ((size_t)bh * SEQ + 64 * c) * 256;
    const int d = tid & 127, t0 = 16 * (tid >> 7), s = tid & 63, vc0 = tid >> 6;
#pragma unroll
    for (int i = 0; i < 16; ++i) { in.g[i] = Gg[(t0 + i) * 128 + d]; in.q[i] = Qg[(t0 + i) * 128 + d]; in.k[i] = Kg[(t0 + i) * 128 + d]; }
#pragma unroll
    for (int ps = 0; ps < 4; ++ps) in.v[ps] = *(const u32x4*)(Vg + s * 256 + 8 * (vc0 + 8 * ps));
}
__device__ __forceinline__ void gla1_item(const P& p, LAS unsigned char* lds, int item, int tid, const G1In& in, bool st) {
    const int bh = item >> 5, c = item & 31, lane = tid & 63, w = __builtin_amdgcn_readfirstlane(tid >> 6);
    bf16* Qg = (bf16*)(p.ws + WS_QA) + ((size_t)bh * SEQ + 64 * c) * 128;
    bf16* Kg = (bf16*)(p.ws + WS_KA) + ((size_t)bh * SEQ + 64 * c) * 128;
    bf16* Vg = (bf16*)(p.ws + WS_VA) + ((size_t)bh * SEQ + 64 * c) * 256;
    LAS float* TOT = (LAS float*)(lds + G1_TOT); LAS bf16* QEl = (LAS bf16*)(lds + G1_QE); LAS bf16* KIl = (LAS bf16*)(lds + G1_KI); LAS bf16* VTl = (LAS bf16*)(lds + G1_VT);
    {
        const int d = tid & 127, qd = tid >> 7, t0 = 16 * qd;
        float bl[16], qv[16], kv[16]; unsigned used = 0u;
#pragma unroll
        for (int i = 0; i < 16; ++i) { bl[i] = in.g[i]; qv[i] = bf2f(in.q[i]); kv[i] = bf2f(in.k[i]); used |= (unsigned)in.q[i] | (unsigned)in.k[i]; }
        used |= in.v[0].x | in.v[1].x | in.v[2].x | in.v[3].x;
#pragma unroll
        for (int i = 1; i < 16; ++i) bl[i] += bl[i - 1];
        TOT[qd * 128 + d] = bl[15];
        asm volatile("" :: "v"(used));
        LDS_WAIT(); __syncthreads();
        const float t0v = TOT[d], t1v = TOT[128 + d], t2v = TOT[256 + d], t3v = TOT[384 + d];
        const float off = (qd > 0 ? t0v : 0.f) + (qd > 1 ? t1v : 0.f) + (qd > 2 ? t2v : 0.f), blast = (t0v + t1v) + (t2v + t3v);
        float ks[16];
#pragma unroll
        for (int i = 0; i < 16; ++i) { const float b = bl[i] + off;
            QEl[(t0 + i) * 136 + d] = f2bf(qv[i] * 0.08838834764831845f * __expf(b)); KIl[(t0 + i) * 136 + d] = f2bf(kv[i] * __expf(-b)); ks[i] = kv[i] * __expf(blast - b); }
        const int D = d >> 5, r = d & 31;
        u32x4 o0, o1; o0.x = cvtpk(ks[0], ks[1]); o0.y = cvtpk(ks[2], ks[3]); o0.z = cvtpk(ks[4], ks[5]); o0.w = cvtpk(ks[6], ks[7]);
        o1.x = cvtpk(ks[8], ks[9]); o1.y = cvtpk(ks[10], ks[11]); o1.z = cvtpk(ks[12], ks[13]); o1.w = cvtpk(ks[14], ks[15]);
        if (st) { *(u32x4*)(Kg + ((D * 4 + qd) * 64 + r) * 8) = o0; *(u32x4*)(Kg + ((D * 4 + qd) * 64 + 32 + r) * 8) = o1; }
        if (qd == 0 && st) ((float*)(p.ws + WS_DEC))[item * 128 + d] = __expf(blast);
    }
    {
        const int s = tid & 63, vc0 = tid >> 6;
#pragma unroll
        for (int ps = 0; ps < 4; ++ps) { const int vc = vc0 + 8 * ps; const u32x4 val = in.v[ps];
            LAS bf16* dst = VTl + (8 * vc) * 72 + s;
            dst[0 * 72] = (bf16)(val.x & 0xffff); dst[1 * 72] = (bf16)(val.x >> 16); dst[2 * 72] = (bf16)(val.y & 0xffff); dst[3 * 72] = (bf16)(val.y >> 16);
            dst[4 * 72] = (bf16)(val.z & 0xffff); dst[5 * 72] = (bf16)(val.z >> 16); dst[6 * 72] = (bf16)(val.w & 0xffff); dst[7 * 72] = (bf16)(val.w >> 16); }
    }
    LDS_WAIT(); __syncthreads();
    {
        const int ti = w & 1, vq = w >> 1, r = lane & 31, hh = lane >> 5;
        bf16x8 qf[8];
#pragma unroll
        for (int kk = 0; kk < 8; ++kk) qf[kk] = *(const LAS bf16x8*)(QEl + (32 * ti + r) * 136 + 16 * kk + 8 * hh);
        f32x16 z0, z1;
#pragma unroll
        for (int i = 0; i < 16; ++i) { z0[i] = 0.f; z1[i] = 0.f; }
#pragma unroll
        for (int si = 0; si < 2; ++si) {
            if (si <= ti) {
                f32x16 X;
#pragma unroll
                for (int i = 0; i < 16; ++i) X[i] = 0.f;
#pragma unroll
                for (int kk = 0; kk < 8; ++kk) { const bf16x8 kf = *(const LAS bf16x8*)(KIl + (32 * si + r) * 136 + 16 * kk + 8 * hh); X = MFMA32(kf, qf[kk], X); }
                if (si == ti) {
#pragma unroll
                    for (int i = 0; i < 16; ++i) X[i] = (crow(i, hh) <= r) ? X[i] : 0.f;
                }
                const bf16x8 x0 = pack_step<0>(X), x1 = pack_step<1>(X);
                const LAS bf16* v0p = VTl + (32 * (2 * vq) + r) * 72 + 32 * si + 4 * hh; const LAS bf16* v1p = v0p + 32 * 72;
                { const s16x4 lo = *(const LAS s16x4*)(v0p), hi = *(const LAS s16x4*)(v0p + 8); z0 = MFMA32(x0, __builtin_shufflevector(lo, hi, 0, 1, 2, 3, 4, 5, 6, 7), z0); }
                { const s16x4 lo = *(const LAS s16x4*)(v0p + 16), hi = *(const LAS s16x4*)(v0p + 24); z0 = MFMA32(x1, __builtin_shufflevector(lo, hi, 0, 1, 2, 3, 4, 5, 6, 7), z0); }
                { const s16x4 lo = *(const LAS s16x4*)(v1p), hi = *(const LAS s16x4*)(v1p + 8); z1 = MFMA32(x0, __builtin_shufflevector(lo, hi, 0, 1, 2, 3, 4, 5, 6, 7), z1); }
                { const s16x4 lo = *(const LAS s16x4*)(v1p + 16), hi = *(const LAS s16x4*)(v1p + 24); z1 = MFMA32(x1, __builtin_shufflevector(lo, hi, 0, 1, 2, 3, 4, 5, 6, 7), z1); }
            }
        }
        bf16* OI = (bf16*)(p.ws + WS_OI);
        { u32x4 a, b; a.x = cvtpk(z0[0], z0[1]); a.y = cvtpk(z0[2], z0[3]); a.z = cvtpk(z0[4], z0[5]); a.w = cvtpk(z0[6], z0[7]); b.x = cvtpk(z0[8], z0[9]); b.y = cvtpk(z0[10], z0[11]); b.z = cvtpk(z0[12], z0[13]); b.w = cvtpk(z0[14], z0[15]);
          bf16* dst = OI + ((((size_t)item * 8 + 2 * vq) * 2 + ti) * 64 + lane) * 16; if (st) { *(u32x4*)dst = a; *(u32x4*)(dst + 8) = b; } }
        { u32x4 a, b; a.x = cvtpk(z1[0], z1[1]); a.y = cvtpk(z1[2], z1[3]); a.z = cvtpk(z1[4], z1[5]); a.w = cvtpk(z1[6], z1[7]); b.x = cvtpk(z1[8], z1[9]); b.y = cvtpk(z1[10], z1[11]); b.z = cvtpk(z1[12], z1[13]); b.w = cvtpk(z1[14], z1[15]);
          bf16* dst = OI + ((((size_t)item * 8 + 2 * vq + 1) * 2 + ti) * 64 + lane) * 16; if (st) { *(u32x4*)dst = a; *(u32x4*)(dst + 8) = b; } }
    }
    {
        const int r = lane & 31, hh = lane >> 5;
#pragma unroll
        for (int ps = 0; ps < 2; ++ps) { const int f = w + 8 * ps, i = f >> 3, D = (f >> 1) & 3, s2 = f & 1;
            const LAS bf16* src = QEl + (32 * i + r) * 136 + 32 * D + 16 * s2 + 4 * hh;
            const u32x2 lo = *(const LAS u32x2*)src, hi = *(const LAS u32x2*)(src + 8);
            if (st) *(u32x4*)(Qg + (f * 64 + lane) * 8) = (u32x4){lo.x, lo.y, hi.x, hi.y}; }
#pragma unroll
        for (int ps = 0; ps < 4; ++ps) { const int ci = tid + 512 * ps, v = ci >> 3, sc = ci & 7;
            const u32x4 tv = *(const LAS u32x4*)(VTl + v * 72 + 8 * sc); if (st) *(u32x4*)(Vg + v * 64 + 8 * sc) = tv; }
    }
    LDS_WAIT(); __syncthreads();
}

__device__ __forceinline__ void swa_unit(const P& p, int l, LAS unsigned char* lds, int unit, int tid, bool st) {
    const int b = unit >> 7, kvh = (unit >> 6) & 1, qb = unit & 63, lane = tid & 63, g = __builtin_amdgcn_readfirstlane(tid >> 6), r = lane & 31, hh = lane >> 5;
    const int kb0 = 32 * qb - 128; const size_t tokb = (size_t)b * SEQ;
    LAS bf16* VTl = (LAS bf16*)lds;
    const bf16* VB = (const bf16*)(p.ws + WS_VB); const bf16* KB = (const bf16*)(p.ws + WS_KB); bf16* QB = (bf16*)(p.ws + WS_QB);
    for (int ci = tid; ci < 1280; ci += NTHR) { const int key = ci % 160, dc = ci / 160, kp = kb0 + key;
        u32x4 val = {0u, 0u, 0u, 0u}; if (kp >= 0) val = *(const u32x4*)(VB + (tokb + kp) * 128 + kvh * 64 + 8 * dc);
        LAS bf16* dst = VTl + (8 * dc) * 168 + key;
        dst[0 * 168] = (bf16)(val.x & 0xffff); dst[1 * 168] = (bf16)(val.x >> 16); dst[2 * 168] = (bf16)(val.y & 0xffff); dst[3 * 168] = (bf16)(val.y >> 16);
        dst[4 * 168] = (bf16)(val.z & 0xffff); dst[5 * 168] = (bf16)(val.z >> 16); dst[6 * 168] = (bf16)(val.w & 0xffff); dst[7 * 168] = (bf16)(val.w >> 16); }
    const int hq = kvh * 8 + g;
    bf16* Qrow = QB + (tokb + 32 * qb + r) * 1024 + hq * 64;
    bf16x8 qf[4];
#pragma unroll
    for (int kk = 0; kk < 4; ++kk) qf[kk] = *(const bf16x8*)(Qrow + 16 * kk + 8 * hh);
    f32x16 X[5];
#pragma unroll
    for (int kt = 0; kt < 5; ++kt) {
#pragma unroll
        for (int i = 0; i < 16; ++i) X[kt][i] = 0.f;
        const int kp = kb0 + 32 * kt + r, kpc = kp < 0 ? 0 : kp;
        const bf16* Krow = KB + (tokb + kpc) * 128 + kvh * 64 + 8 * hh;
#pragma unroll
        for (int kk = 0; kk < 4; ++kk) { const bf16x8 kf = *(const bf16x8*)(Krow + 16 * kk); X[kt] = MFMA32(kf, qf[kk], X[kt]); }
    }
    const int qp = 32 * qb + r; const float sink = p.sinks[l * 16 + hq];
    float mx = -1e30f;
#pragma unroll
    for (int kt = 0; kt < 5; ++kt)
#pragma unroll
        for (int i = 0; i < 16; ++i) { const int kp = kb0 + 32 * kt + crow(i, hh); const bool valid = (kp >= 0) && (kp <= qp) && (kp > qp - 128);
            X[kt][i] = valid ? X[kt][i] : -1e30f; mx = fmaxf(mx, X[kt][i]); }
    mx = fmaxf(mx, shx(mx, 32, lane)); mx = fmaxf(mx, sink);
    float sum = 0.f;
#pragma unroll
    for (int kt = 0; kt < 5; ++kt)
#pragma unroll
        for (int i = 0; i < 16; ++i) { const float pv = (X[kt][i] > -1e29f) ? __expf(X[kt][i] - mx) : 0.f; X[kt][i] = pv; sum += pv; }
    sum += shx(sum, 32, lane);
    const float inv = 1.0f / (sum + __expf(sink - mx));
    LDS_WAIT(); __syncthreads();
    f32x16 o0, o1;
#pragma unroll
    for (int i = 0; i < 16; ++i) { o0[i] = 0.f; o1[i] = 0.f; }
#pragma unroll
    for (int kt = 0; kt < 5; ++kt) {
        const bf16x8 x0 = pack_step<0>(X[kt]), x1 = pack_step<1>(X[kt]);
        const LAS bf16* v0p = VTl + r * 168 + 32 * kt + 4 * hh; const LAS bf16* v1p = v0p + 32 * 168;
        { const s16x4 lo = *(const LAS s16x4*)(v0p), hi = *(const LAS s16x4*)(v0p + 8); o0 = MFMA32(__builtin_shufflevector(lo, hi, 0, 1, 2, 3, 4, 5, 6, 7), x0, o0); }
        { const s16x4 lo = *(const LAS s16x4*)(v0p + 16), hi = *(const LAS s16x4*)(v0p + 24); o0 = MFMA32(__builtin_shufflevector(lo, hi, 0, 1, 2, 3, 4, 5, 6, 7), x1, o0); }
        { const s16x4 lo = *(const LAS s16x4*)(v1p), hi = *(const LAS s16x4*)(v1p + 8); o1 = MFMA32(__builtin_shufflevector(lo, hi, 0, 1, 2, 3, 4, 5, 6, 7), x0, o1); }
        { const s16x4 lo = *(const LAS s16x4*)(v1p + 16), hi = *(const LAS s16x4*)(v1p + 24); o1 = MFMA32(__builtin_shufflevector(lo, hi, 0, 1, 2, 3, 4, 5, 6, 7), x1, o1); }
    }
#pragma unroll
    for (int gq = 0; gq < 4; ++gq) {
        u32x2 a; a.x = cvtpk(o0[4 * gq] * inv, o0[4 * gq + 1] * inv); a.y = cvtpk(o0[4 * gq + 2] * inv, o0[4 * gq + 3] * inv);
        u32x2 c; c.x = cvtpk(o1[4 * gq] * inv, o1[4 * gq + 1] * inv); c.y = cvtpk(o1[4 * gq + 2] * inv, o1[4 * gq + 3] * inv);
        if (st) { *(u32x2*)(Qrow + 8 * gq + 4 * hh) = a; *(u32x2*)(Qrow + 32 + 8 * gq + 4 * hh) = c; }
    }
    __syncthreads();
}

constexpr int G2_QE = 0, G2_KS = 32768, G2_DEC = 65536, G2_GL = 66560, G2_OL = 67584;
#define GLDS16(gp, lp) __builtin_amdgcn_global_load_lds((const unsigned*)(gp), (LAS unsigned*)(lp), 16, 0, 0)
#define GLDS4(gp, lp) __builtin_amdgcn_global_load_lds((const unsigned*)(gp), (LAS unsigned*)(lp), 4, 0, 0)
__device__ __forceinline__ void gla2_bh(const P& p, int l, LAS unsigned char* lds, int bh, int tid_in, bool st) {
    int tid = tid_in; asm volatile("" : "+v"(tid));
    { int t2 = tid; asm volatile("" : "+v"(t2));
      if (t2 < 64) { const f32x4 gv = *(const f32x4*)(p.glag + l * 256 + 4 * t2); *(LAS f32x4*)(lds + G2_GL + t2 * 16) = gv; } }
    const int lane = tid & 63, w = __builtin_amdgcn_readfirstlane(tid >> 6), r = lane & 31, hh = lane >> 5, b = bh >> 2, h = bh & 3;
    LAS bf16* Olb = (LAS bf16*)(lds + G2_OL);
    f32x16 S0, S1, S2, S3;
#pragma unroll
    for (int i = 0; i < 16; ++i) { S0[i] = 0.f; S1[i] = 0.f; S2[i] = 0.f; S3[i] = 0.f; }
    const char* Qbase = (const char*)((const bf16*)(p.ws + WS_QA) + (size_t)bh * SEQ * 128);
    const char* Kbase = (const char*)((const bf16*)(p.ws + WS_KA) + (size_t)bh * SEQ * 128);
    const char* Vu = (const char*)(p.ws + WS_VA) + (size_t)bh * SEQ * 256 * 2; const unsigned vo = (unsigned)(((32 * w + r) * 64 + 8 * hh) * 2);
    const char* OIu = (const char*)(p.ws + WS_OI) + (size_t)bh * 32 * 8 * 2 * 64 * 16 * 2; const unsigned oo = (unsigned)(((w * 2 * 64 + lane) * 16) * 2);
    const float* DECbase = (const float*)(p.ws + WS_DEC) + (size_t)bh * 32 * 128;
    const int t = tid >> 3, seg = tid & 7;
    char* Ru = (char*)(p.ws + WS_RA) + ((size_t)b * SEQ * 1024 + h * 256) * 2; const unsigned ro = (unsigned)((t * 1024 + 32 * seg) * 2);
    const LAS float* gg = (const LAS float*)(lds + G2_GL) + 32 * seg;
#define G2_ISSUE(c_, B_) do { const int c__ = (c_); constexpr int buf__ = (B_); \
        if (w < 4) { _Pragma("unroll") for (int q = 0; q < 4; ++q) GLDS16(Qbase + (size_t)c__ * 16384 + (4 * w + q) * 1024 + lane * 16, lds + G2_QE + buf__ * 16384 + (4 * w + q) * 1024); } \
        else { _Pragma("unroll") for (int q = 0; q < 4; ++q) GLDS16(Kbase + (size_t)c__ * 16384 + (4 * (w - 4) + q) * 1024 + lane * 16, lds + G2_KS + buf__ * 16384 + (4 * (w - 4) + q) * 1024); } \
        if (w < 2) GLDS4(DECbase + c__ * 128 + 64 * w + lane, lds + G2_DEC + buf__ * 512 + 256 * w); } while (0)
#define G2_LOADV(c_, V_) do { const int c__ = (c_); \
        _Pragma("unroll") for (int ks = 0; ks < 4; ++ks) V_[ks] = *(const bf16x8*)(Vu + (size_t)c__ * (64 * 256 * 2) + vo + 32 * ks); } while (0)
#define G2_LOADOR(c_, O_) do { const int c__ = (c_); \
        const char* ob__ = OIu + (size_t)c__ * (8 * 2 * 64 * 16 * 2) + oo; \
        O_[0] = *(const u32x4*)(ob__); O_[1] = *(const u32x4*)(ob__ + 16); O_[2] = *(const u32x4*)(ob__ + 64 * 16 * 2); O_[3] = *(const u32x4*)(ob__ + 64 * 16 * 2 + 16); } while (0)
#define G2_LOADRA(c_, R_) do { const int c__ = (c_); _Pragma("unroll") for (int q = 0; q < 4; ++q) R_[q] = *(const u32x4*)(Ru + (size_t)c__ * (64 * 1024 * 2) + ro + 16 * q); } while (0)
    bf16x8 vc[4], vn[4]; u32x4 oc[4], rc[4], on[4];
    G2_ISSUE(0, 0); G2_LOADV(0, vc); G2_LOADOR(0, oc);
#pragma unroll
    for (int q = 0; q < 4; ++q) { vn[q] = vc[q]; on[q] = oc[q]; }
#define G2_NORM(c_, OB_) do {   \
            const LAS bf16* Orow = Olb + (OB_) * (64 * 264) + t * 264 + 32 * seg; u32x4 ow[4]; float ss = 0.f; \
            _Pragma("unroll") for (int q = 0; q < 4; ++q) { ow[q] = *(const LAS u32x4*)(Orow + 8 * q); const f32x4 x0 = bflo4((u32x2){ow[q].x, ow[q].y}), x1 = bflo4((u32x2){ow[q].z, ow[q].w}); \
                ss += ((x0[0] * x0[0] + x0[1] * x0[1]) + (x0[2] * x0[2] + x0[3] * x0[3])) + ((x1[0] * x1[0] + x1[1] * x1[1]) + (x1[2] * x1[2] + x1[3] * x1[3])); } \
            ss += shx(ss, 1, lane); ss += shx(ss, 2, lane); ss += shx(ss, 4, lane); \
            const float rstd = 1.0f / sqrtf(ss * (1.0f / 256.0f) + EPS); \
            bf16* R = (bf16*)(Ru + (size_t)(c_) * (64 * 1024 * 2) + ro); \
            _Pragma("unroll") for (int q = 0; q < 4; ++q) { const u32x4 rv = rc[q]; const f32x4 g0 = *(const LAS f32x4*)(gg + 8 * q), g1 = *(const LAS f32x4*)(gg + 8 * q + 4); \
                const f32x4 a = bflo4((u32x2){ow[q].x, ow[q].y}) * rstd * g0 * bflo4((u32x2){rv.x, rv.y}), bq = bflo4((u32x2){ow[q].z, ow[q].w}) * rstd * g1 * bflo4((u32x2){rv.z, rv.w}); \
                if (st) *(u32x4*)(R + 8 * q) = pack8(a, bq); } } while (0)
#define G2_STEP(c_, BUF_) do { const int c = (c_); \
        __builtin_amdgcn_s_waitcnt(0x0F70)  ; LDS_WAIT(); __builtin_amdgcn_s_barrier(); asm volatile("" ::: "memory"); \
        if (c + 1 < 32) { G2_ISSUE(c + 1, 1 - (BUF_)); G2_LOADV(c + 1, vn); G2_LOADOR(c + 1, on); }       \
        if (c > 0) G2_NORM(c - 1, 1 - (BUF_)); \
        G2_LOADRA(c, rc); \
        const LAS unsigned char* QEb = lds + G2_QE + (BUF_) * 16384 + lane * 16; const LAS unsigned char* KSb = lds + G2_KS + (BUF_) * 16384 + lane * 16; \
        const LAS float* DECb = (const LAS float*)(lds + G2_DEC + (BUF_) * 512); \
        LAS bf16* Ow = Olb + (BUF_) * (64 * 264) + 32 * w + r; \
        f32x16 o0; bf16x8 fa[8]; \
        _Pragma("unroll") for (int f = 0; f < 8; ++f) fa[f] = *(const LAS bf16x8*)(QEb + f * 1024);            \
        G2_UNPK(o0, oc[0], oc[1]); \
        o0 = MFMA32(fa[0], pack_step<0>(S0), o0); o0 = MFMA32(fa[1], pack_step<1>(S0), o0); o0 = MFMA32(fa[2], pack_step<0>(S1), o0); o0 = MFMA32(fa[3], pack_step<1>(S1), o0); \
        o0 = MFMA32(fa[4], pack_step<0>(S2), o0); o0 = MFMA32(fa[5], pack_step<1>(S2), o0); o0 = MFMA32(fa[6], pack_step<0>(S3), o0); o0 = MFMA32(fa[7], pack_step<1>(S3), o0); \
        _Pragma("unroll") for (int f = 0; f < 8; ++f) fa[f] = *(const LAS bf16x8*)(QEb + (8 + f) * 1024); \
        _Pragma("unroll") for (int i = 0; i < 16; i += 2) { const unsigned pw = cvtpk(o0[i], o0[i + 1]); Ow[crow(i, hh) * 264] = (bf16)(pw & 0xffff); Ow[crow(i + 1, hh) * 264] = (bf16)(pw >> 16); } \
        G2_UNPK(o0, oc[2], oc[3]); \
        o0 = MFMA32(fa[0], pack_step<0>(S0), o0); o0 = MFMA32(fa[1], pack_step<1>(S0), o0); o0 = MFMA32(fa[2], pack_step<0>(S1), o0); o0 = MFMA32(fa[3], pack_step<1>(S1), o0); \
        o0 = MFMA32(fa[4], pack_step<0>(S2), o0); o0 = MFMA32(fa[5], pack_step<1>(S2), o0); o0 = MFMA32(fa[6], pack_step<0>(S3), o0); o0 = MFMA32(fa[7], pack_step<1>(S3), o0); \
        _Pragma("unroll") for (int f = 0; f < 8; ++f) fa[f] = *(const LAS bf16x8*)(KSb + f * 1024); \
        _Pragma("unroll") for (int i = 0; i < 16; i += 2) { const unsigned pw = cvtpk(o0[i], o0[i + 1]); Ow[(32 + crow(i, hh)) * 264] = (bf16)(pw & 0xffff); Ow[(32 + crow(i + 1, hh)) * 264] = (bf16)(pw >> 16); } \
        GLA2_DECAY(0, S0); GLA2_DECAY(1, S1); \
        _Pragma("unroll") for (int ks = 0; ks < 4; ++ks) { S0 = MFMA32(fa[ks], vc[ks], S0); S1 = MFMA32(fa[4 + ks], vc[ks], S1); } \
        _Pragma("unroll") for (int f = 0; f < 8; ++f) fa[f] = *(const LAS bf16x8*)(KSb + (8 + f) * 1024); \
        GLA2_DECAY(2, S2); GLA2_DECAY(3, S3); \
        _Pragma("unroll") for (int ks = 0; ks < 4; ++ks) { S2 = MFMA32(fa[ks], vc[ks], S2); S3 = MFMA32(fa[4 + ks], vc[ks], S3); } \
        _Pragma("unroll") for (int q = 0; q < 4; ++q) { vc[q] = vn[q]; oc[q] = on[q]; } } while (0)
#define G2_UNPK(O_, A_, B_) do { O_[0] = lo16(A_.x); O_[1] = hi16(A_.x); O_[2] = lo16(A_.y); O_[3] = hi16(A_.y); O_[4] = lo16(A_.z); O_[5] = hi16(A_.z); O_[6] = lo16(A_.w); O_[7] = hi16(A_.w); \
            O_[8] = lo16(B_.x); O_[9] = hi16(B_.x); O_[10] = lo16(B_.y); O_[11] = hi16(B_.y); O_[12] = lo16(B_.z); O_[13] = hi16(B_.z); O_[14] = lo16(B_.w); O_[15] = hi16(B_.w); } while (0)
#define GLA2_DECAY(D, SD) do { _Pragma("unroll") for (int gq = 0; gq < 4; ++gq) { const f32x4 dv = *(const LAS f32x4*)(DECb + 32 * (D) + 8 * gq + 4 * hh); \
                SD[4 * gq] *= dv[0]; SD[4 * gq + 1] *= dv[1]; SD[4 * gq + 2] *= dv[2]; SD[4 * gq + 3] *= dv[3]; } } while (0)
    for (int c2 = 0; c2 < 32; c2 += 2) { G2_STEP(c2, 0); G2_STEP(c2 + 1, 1); }
    __builtin_amdgcn_s_waitcnt(0x0F70); LDS_WAIT(); __builtin_amdgcn_s_barrier(); asm volatile("" ::: "memory");
    G2_NORM(31, 1);
#undef G2_STEP
#undef G2_NORM
#undef G2_UNPK
#undef GLA2_DECAY
    VM_WAIT(); LDS_WAIT(); __builtin_amdgcn_s_barrier(); asm volatile("" ::: "memory");
#undef G2_ISSUE
#undef G2_LOADV
#undef G2_LOADOR
#undef G2_LOADRA
}

__device__ __forceinline__ void t2_group(const P& p, int l, LAS unsigned char* lds, int grp, int tid, bool st) {
    const int lane = tid & 63, w = __builtin_amdgcn_readfirstlane(tid >> 6);
    LAS int* REl = (LAS int*)(lds + LX_RE); LAS int* RKl = (LAS int*)(lds + LX_RANK); LAS int* BSl = (LAS int*)(lds + LX_BASE);
    const float* modl = (const float*)(p.ws + WS_MOD) + (size_t)l * 8 * NMOD;
    LAS float* rwt = (LAS float*)lds;
    for (int ci = tid; ci < 4096; ci += NTHR) { const int k = ci >> 2, e0 = (ci & 3) * 4; const f32x4 r = *(const f32x4*)(p.rw + k * 16 + e0);
        rwt[(e0 + 0) * 1024 + k] = r[0]; rwt[(e0 + 1) * 1024 + k] = r[1]; rwt[(e0 + 2) * 1024 + k] = r[2]; rwt[(e0 + 3) * 1024 + k] = r[3]; }
    LDS_WAIT(); __syncthreads();
    f32x4 vc[4], vn[4]; const float* Xp = (const float*)(p.ws + WS_X);
    row_load(Xp, grp * 64 + w * 8, lane, vc);
#pragma unroll
    for (int j = 0; j < 4; ++j) vn[j] = vc[j];
#pragma unroll 1
    for (int i = 0; i < 8; ++i) { const int tl = w * 8 + i;
        if (i + 1 < 8) row_load(Xp, grp * 64 + tl + 1, lane, vn);
        token_row(p, l, grp * 64 + tl, lane, st ? 8 : (8 | 64), vc, p.n2g + l * DM, modl + 4096, modl + 3072, nullptr, 0, REl + 2 * tl, rwt);
#pragma unroll
        for (int j = 0; j < 4; ++j) vc[j] = vn[j]; }
    LDS_WAIT(); __syncthreads();
    unsigned* CNT = (unsigned*)(p.ws + WS_CTL) + CW_CNT + 64 * l;
    if (tid < 16) { int cnt = 0;
        for (int q = 0; q < 128; ++q) if (REl[q] == tid) RKl[q] = cnt++;
        BSl[tid] = st ? (int)__hip_atomic_fetch_add(CNT + tid, (unsigned)cnt, __ATOMIC_RELAXED, __HIP_MEMORY_SCOPE_AGENT) : 0; }
    LDS_WAIT(); __syncthreads();
    if (tid < 128 && st) { const int e = REl[tid], slot = BSl[e] + RKl[tid], tok = grp * 64 + (tid >> 1);
        ((unsigned*)(p.ws + WS_RS))[2 * tok + (tid & 1)] = (unsigned)slot; ((int*)(p.ws + WS_ROWIDX))[e * NTOK + slot] = tok; }
    __syncthreads();
}
__device__ __forceinline__ void moe_setup(const P& p, int l, LAS unsigned char* lds, int tid, int G, int c, bool rows) {
    LAS int* TS = (LAS int*)(lds + LX_TS); LAS int* CN = (LAS int*)(lds + LX_CNT); LAS unsigned* RT = (LAS unsigned*)(lds + LX_ROWS);
    const unsigned* CNT = (const unsigned*)(p.ws + WS_CTL) + CW_CNT + 64 * l;
    if (tid < 64) { const int cn = tid < 16 ? (int)CNT[tid] : 0; const int tl = (cn + 255) >> 8; int s = tl;
#pragma unroll
        for (int o = 1; o < 16; o <<= 1) { const int t = shl_from(s, tid - o); if ((tid & 15) >= o) s += t; }
        if (tid < 16) { TS[tid] = s - tl; CN[tid] = cn; if (tid == 15) TS[16] = s; } }
    LDS_WAIT(); __syncthreads();
    if (rows) {
        for (int i = 0; i < 4; ++i) { const int L = i * G + c; if (L >= 4 * TS[16]) break;
            const int rt = L >> 2; int e = 0;
#pragma unroll
            for (int q = 1; q < 16; ++q) e += (rt >= TS[q]) ? 1 : 0;
            if (tid < 256) { const int slot = 256 * (rt - TS[e]) + tid; const int tok = slot < CN[e] ? ((const int*)(p.ws + WS_ROWIDX))[e * NTOK + slot] : 0; RT[i * 256 + tid] = (unsigned)tok * 2048u; } }
        LDS_WAIT(); __syncthreads();
    }
}
constexpr int N_PHASES = 38;
#ifndef MK_MASK
#define MK_MASK 0x7ff
#endif
#define PH_ON(b) ((MK_MASK >> (b)) & 1)
#ifndef REP_PRO
#define REP_PRO 0
#endif
#ifndef REP_G1
#define REP_G1 0
#endif
#ifndef REP_G2
#define REP_G2 0
#endif
#ifndef REP_G4
#define REP_G4 0
#endif
#ifndef REP_G5
#define REP_G5 0
#endif
#ifndef DRY_GLA1
#define DRY_GLA1 0
#endif
#ifndef DRY_SWA
#define DRY_SWA 0
#endif
#ifndef DRY_GLA2
#define DRY_GLA2 0
#endif
#ifndef PROBE_G1_NOST
#define PROBE_G1_NOST 0
#endif
#ifndef PROBE_G1_NOEPI
#define PROBE_G1_NOEPI 0
#endif
#ifndef PROBE_G1_HOT
#define PROBE_G1_HOT 0
#endif
#ifndef A2_DRY_PART
#define A2_DRY_PART 0
#endif
struct MKArgs { P p; int ph_lo, ph_hi, dry, pad; };
typedef const __attribute__((address_space(4))) MKArgs* KArgP;
#if defined(__HIP_DEVICE_COMPILE__)
#define PHASE_LOADP() KArgP kp_ = (KArgP)__builtin_amdgcn_kernarg_segment_ptr(); asm volatile("" : "+s"(kp_)); P p; p.x = kp_->p.x; p.c = kp_->p.c; p.pos = kp_->p.pos; p.ada_w = kp_->p.ada_w; p.ada_b = kp_->p.ada_b; p.n1g = kp_->p.n1g; p.n2g = kp_->p.n2g; p.fg = kp_->p.fg; p.w_in = kp_->p.w_in; p.aw = kp_->p.aw; p.ab = kp_->p.ab; p.glag = kp_->p.glag; p.sinks = kp_->p.sinks; p.w_pa = kp_->p.w_pa; p.w_pb = kp_->p.w_pb; p.w_out = kp_->p.w_out; p.rw = kp_->p.rw; p.rb = kp_->p.rb; p.wg = kp_->p.wg; p.wu = kp_->p.wu; p.wd = kp_->p.wd; p.out = kp_->p.out; p.ws = kp_->p.ws;
#else
#define PHASE_LOADP() const P p = a.p;
#endif
#define PHASE_ENV() PHASE_LOADP() \
    int tid; asm volatile("v_mbcnt_lo_u32_b32 %0, -1, 0\n\tv_mbcnt_hi_u32_b32 %0, -1, %0" : "=v"(tid)); tid += wave_s * 64; int bid = blockIdx.x; asm volatile("" : "+s"(bid)); int G = gridDim.x; asm volatile("" : "+s"(G)); \
    const int lane = tid & 63, wave = __builtin_amdgcn_readfirstlane(tid >> 6); (void)lane; (void)wave; \
    unsigned* ctl = (unsigned*)(p.ws + WS_CTL); const float* MOD = (const float*)(p.ws + WS_MOD); float* X = (float*)(p.ws + WS_X); (void)ctl; (void)MOD; (void)X;
__global__ void __launch_bounds__(NTHR, 2) mk(MKArgs a) {
    extern __shared__ __attribute__((aligned(16))) unsigned char lds_raw[];
    LAS unsigned char* lds = (LAS unsigned char*)lds_raw;
    const int lo = a.ph_lo, hi = a.ph_hi; const bool st_all = (a.dry == 0);
    const int wave_s = __builtin_amdgcn_readfirstlane(threadIdx.x >> 6);
    for (int u = threadIdx.x; u < (LDS_BYTES - LX_OFF) / 4; u += NTHR) ((LAS unsigned*)(lds + LX_OFF))[u] = 0u;
    __syncthreads();
    XcdBarrier bar; bar.bar = (unsigned*)(a.p.ws + WS_CTL) + CW_BAR; bar.x = 0; bar.st = (volatile LAS unsigned*)(lds + LX_BAR);
    if (hi - lo > 1) bar = xcd_barrier_post((unsigned*)(a.p.ws + WS_CTL) + CW_BAR, (volatile LAS unsigned*)(lds + LX_BAR));
#define IN(k) (lo <= (k) && (k) < hi)
#define SEAM(k) do { if (IN(k) && IN((k) + 1)) xcd_barrier(bar); } while (0)

    if (IN(0) && PH_ON(0)) {
        PHASE_ENV();
        for (int rep = 0; rep <= REP_PRO; ++rep) {
        prologue_mod(p, lds, bid, G, tid);
        for (int idx = bid * NTHR + tid; idx < NTOK * 32; idx += G * NTHR) rope_entry(p.pos, (float2*)(p.ws + WS_ROPE), idx);
        conv_layer_static(p, 0, lds, bid * NWAVES + wave, G * NWAVES, wave, lane);
        if (!CONV_OVERLAP) { for (int ll = 1; ll < NL; ++ll) conv_layer_static(p, ll, lds, bid * NWAVES + wave, G * NWAVES, wave, lane); }
        __syncthreads(); }
    }
    SEAM(0);
    for (int l = 0; l < NL; ++l) {
        const int base = 1 + 9 * l;
        if (IN(base + 0) && PH_ON(1)) {
            PHASE_ENV();
            const float* modl = MOD + (size_t)l * 8 * NMOD;
            const int mode = (l > 0 ? (1 | 16) : 0) | 2 | (st_all ? 0 : 64);
            const int startv = (l > 0) ? expert_start_lane(ctl + CW_CNT + 64 * (l - 1), lane) : 0;
            const float* xin = (l == 0) ? p.x : (const float*)X;
            const float* g2prev = MOD + (size_t)(l > 0 ? l - 1 : 0) * 8 * NMOD + 5120;
            if (l > 0 && CONV_OVERLAP) conv_layer_dynamic(p, l, lds, wave, lane, -1);
            { f32x4 vc[4], vn[4]; const int m0 = bid * NWAVES + wave, stp = G * NWAVES;
#pragma unroll
              for (int j = 0; j < 4; ++j) vc[j] = (f32x4){0.f, 0.f, 0.f, 0.f};
              if (m0 < NTOK) row_load(xin, m0, lane, vc);
#pragma unroll
              for (int j = 0; j < 4; ++j) vn[j] = vc[j];
              for (int m = m0; m < NTOK; m += stp) { if (m + stp < NTOK) row_load(xin, m + stp, lane, vn);
                  token_row(p, l, m, lane, mode, vc, p.n1g + l * DM, modl + 1024, modl + 0, g2prev, startv, (LAS int*)nullptr);
#pragma unroll
                  for (int j = 0; j < 4; ++j) vc[j] = vn[j]; } }
        }
        SEAM(base + 0);
        if (IN(base + 1) && PH_ON(2)) {
            PHASE_ENV();
            unsigned char* wl = p.ws + WS_W + (size_t)l * WL_STRIDE;
            pg8::SchedStatic S{64, NIN / 256, G, bid, (const char*)(p.ws + WS_H), (const char*)(wl + WL_IN), (size_t)256 * 1024 * 2, (size_t)256 * 1024 * 2};
            EpiInProj E{p.ws, p.ab + l * 512, (PROBE_G1_NOEPI && !st_all), (PROBE_G1_NOST && !st_all)};
            if (PROBE_G1_HOT && !st_all) { S.ta = 0; S.tb = 0; }
            for (int rep = 0; rep <= REP_G1; ++rep) pg8::gemm_phase<EpiInProj, pg8::SchedStatic, false>(lds, tid, 1024, S, E);

        }
        if (IN(base + 1) && PH_ON(2) && l + 1 < NL && CONV_OVERLAP) {
            PHASE_ENV();
            const int nun = 64 * (NIN / 256), mine = (nun - bid + G - 1) / G, mx = (nun + G - 1) / G;
            if (mine < mx) conv_layer_dynamic(p, l + 1, lds, wave, lane, 2 * (mx - mine));
        }
        SEAM(base + 1);
        if (IN(base + 2) && PH_ON(3)) {
            PHASE_ENV();
            const bool never = (p.ws == nullptr);
            (void)never;
            G1In cur, nxt; int it = bid;
            gla1_zero(cur);
            if (it < 1024) gla1_load(p, it, tid, cur);
            nxt = cur;
            for (; it < 1024; it += G) { if (it + G < 1024) gla1_load(p, it + G, tid, nxt); gla1_item(p, lds, it, tid, cur, st_all); cur = nxt; }
        }
        SEAM(base + 2);
        if (IN(base + 3) && PH_ON(4)) {
            {   PHASE_ENV();
                const int NG2 = (G >= 64) ? 32 : (G > 1 ? G / 2 : 1);
                if (bid < NG2 && (st_all || A2_DRY_PART != 2)) { for (int bh = bid; bh < 32; bh += NG2) gla2_bh(p, l, lds, bh, tid, st_all); } }
            {   PHASE_ENV();
                const int NG2 = (G >= 64) ? 32 : (G > 1 ? G / 2 : 1);
                if ((G == 1 || bid >= NG2) && (st_all || A2_DRY_PART != 1)) { const int nsw = (G == 1) ? 1 : G - NG2, first = (G == 1) ? 0 : bid - NG2; for (int u = first; u < 1024; u += nsw) swa_unit(p, l, lds, u, tid, st_all); } }
        }
        SEAM(base + 3);
        if (IN(base + 4) && PH_ON(5)) {
            PHASE_ENV();
            unsigned char* wl = p.ws + WS_W + (size_t)l * WL_STRIDE;
            pg8::SchedPair S{64, 4, G, bid, (const char*)(p.ws + WS_RA), (const char*)(wl + WL_PA), (const char*)(p.ws + WS_QB), (const char*)(wl + WL_PB), (size_t)256 * 1024 * 2, (size_t)256 * 1024 * 2};
            EpiMerge E{p.ws};
            for (int rep = 0; rep <= REP_G2; ++rep) pg8::gemm_phase<EpiMerge, pg8::SchedPair, false>(lds, tid, 1024, S, E);
        }
        SEAM(base + 4);
        if (IN(base + 5) && PH_ON(6)) {
            PHASE_ENV();
            unsigned char* wl = p.ws + WS_W + (size_t)l * WL_STRIDE;
            pg8::SchedStatic S{64, 4, G, bid, (const char*)(p.ws + WS_H), (const char*)(wl + WL_OUT), (size_t)256 * 1024 * 2, (size_t)256 * 1024 * 2};
            EpiResid E{X, MOD + (size_t)l * 8 * NMOD + 2048, st_all};
            pg8::gemm_phase<EpiResid, pg8::SchedStatic, false>(lds, tid, 1024, S, E);
        }
        SEAM(base + 5);
        if (IN(base + 6) && PH_ON(7)) {
            PHASE_ENV();
            for (int grp = bid; grp < NTOK / 64; grp += G) t2_group(p, l, lds, grp, tid, st_all);
        }
        SEAM(base + 6);
        if (IN(base + 7) && PH_ON(8)) {
            PHASE_ENV();
            unsigned char* wl = p.ws + WS_W + (size_t)l * WL_STRIDE;
            moe_setup(p, l, lds, tid, G, bid, true);
            pg8::SchedMoe S{G, bid, (const LAS int*)(lds + LX_TS), (const LAS unsigned*)(lds + LX_ROWS), (const char*)(p.ws + WS_H), (const char*)(wl + WL_GU), (size_t)0, (size_t)1024 * 1024 * 2, (size_t)256 * 1024 * 2};
            EpiMoeUp E{(bf16*)(p.ws + WS_HID)};
            for (int rep = 0; rep <= REP_G4; ++rep) pg8::gemm_phase<EpiMoeUp, pg8::SchedMoe, true>(lds, tid, 1024, S, E);

        }
        if (IN(base + 7) && PH_ON(8) && l + 1 < NL && CONV_OVERLAP) {
            PHASE_ENV();
            const int nun = 4 * ((const LAS int*)(lds + LX_TS))[16], mine = nun > bid ? (nun - bid + G - 1) / G : 0, mx = (nun + G - 1) / G;
            if (mine < mx) conv_layer_dynamic(p, l + 1, lds, wave, lane, 2 * (mx - mine));
        }
        SEAM(base + 7);
        if (IN(base + 8) && PH_ON(9)) {
            PHASE_ENV();
            unsigned char* wl = p.ws + WS_W + (size_t)l * WL_STRIDE;
            moe_setup(p, l, lds, tid, G, bid, false);
            pg8::SchedMoe S{G, bid, (const LAS int*)(lds + LX_TS), (const LAS unsigned*)(lds + LX_ROWS), (const char*)(p.ws + WS_HID), (const char*)(wl + WL_D), (size_t)256 * 512 * 2, (size_t)1024 * 512 * 2, (size_t)256 * 512 * 2};
            EpiMoeDown E{(bf16*)(p.ws + WS_Y)};
            for (int rep = 0; rep <= REP_G5; ++rep) pg8::gemm_phase<EpiMoeDown, pg8::SchedMoe, false>(lds, tid, 512, S, E);

        }
        if (IN(base + 8) && PH_ON(9) && l + 1 < NL && CONV_OVERLAP) {
            PHASE_ENV();
            const int nun = 4 * ((const LAS int*)(lds + LX_TS))[16], mine = nun > bid ? (nun - bid + G - 1) / G : 0, mx = (nun + G - 1) / G;
            if (mine < mx) conv_layer_dynamic(p, l + 1, lds, wave, lane, (mx - mine));
        }
        SEAM(base + 8);
    }
    if (IN(N_PHASES - 1) && PH_ON(10)) {
        PHASE_ENV();
        const int startv = expert_start_lane(ctl + CW_CNT + 64 * (NL - 1), lane);
        const float* g2prev = MOD + (size_t)(NL - 1) * 8 * NMOD + 5120;
        { f32x4 vc[4], vn[4]; const int m0 = bid * NWAVES + wave, stp = G * NWAVES;
#pragma unroll
          for (int j = 0; j < 4; ++j) vc[j] = (f32x4){0.f, 0.f, 0.f, 0.f};
          if (m0 < NTOK) row_load((const float*)X, m0, lane, vc);
#pragma unroll
          for (int j = 0; j < 4; ++j) vn[j] = vc[j];
          for (int m = m0; m < NTOK; m += stp) { if (m + stp < NTOK) row_load((const float*)X, m + stp, lane, vn);
              token_row(p, NL, m, lane, 1 | 16 | 4 | (st_all ? 0 : 64), vc, p.fg, MOD, MOD, g2prev, startv, (LAS int*)nullptr);
#pragma unroll
              for (int j = 0; j < 4; ++j) vc[j] = vn[j]; } }
    }
#undef IN
#undef SEAM
}

#ifndef MK_PER_PHASE
#define MK_PER_PHASE 0
#endif
#ifndef PROBE_DUP_KIND
#define PROBE_DUP_KIND -1
#endif
#ifndef PROBE_DUP_N
#define PROBE_DUP_N 3
#endif
extern "C" void kernel_launch(void* const* d_in, const int* in_sizes, int n_in, void* d_out, int out_size, void* d_ws, size_t ws_size, hipStream_t stream) {
    if (n_in != 21 || out_size != NTOK * DM || ws_size < WS_END) { fprintf(stderr, "kernel_launch: unexpected shapes (n_in %d out %d ws %zu)\n", n_in, out_size, ws_size); return; }
    static int grid = 0;
    if (grid == 0) {
        int dev = 0, cus = 0, per_cu = 0;
        if (hipGetDevice(&dev) != hipSuccess || hipDeviceGetAttribute(&cus, hipDeviceAttributeMultiprocessorCount, dev) != hipSuccess) { grid = -1; return; }
        if (hipFuncSetAttribute((const void*)mk, hipFuncAttributeMaxDynamicSharedMemorySize, LDS_BYTES) != hipSuccess) { fprintf(stderr, "kernel_launch: hipFuncSetAttribute failed\n"); grid = -1; return; }
        if (hipOccupancyMaxActiveBlocksPerMultiprocessor(&per_cu, (const void*)mk, NTHR, LDS_BYTES) != hipSuccess || per_cu < 1) fprintf(stderr, "kernel_launch: occupancy query says %d\n", per_cu);
        (void)hipGetLastError();
        grid = cus < 256 ? cus : 256;
    }
    if (grid < 0) return;
    MKArgs a{};
    P& p = a.p;
    p.x = (const float*)d_in[0]; p.c = (const float*)d_in[1]; p.pos = (const int*)d_in[2]; p.ada_w = (const float*)d_in[3]; p.ada_b = (const float*)d_in[4];
    p.n1g = (const float*)d_in[5]; p.n2g = (const float*)d_in[6]; p.fg = (const float*)d_in[7]; p.w_in = (const float*)d_in[8]; p.aw = (const float*)d_in[9]; p.ab = (const float*)d_in[10];
    p.glag = (const float*)d_in[11]; p.sinks = (const float*)d_in[12]; p.w_pa = (const float*)d_in[13]; p.w_pb = (const float*)d_in[14]; p.w_out = (const float*)d_in[15];
    p.rw = (const float*)d_in[16]; p.rb = (const float*)d_in[17]; p.wg = (const float*)d_in[18]; p.wu = (const float*)d_in[19]; p.wd = (const float*)d_in[20];
    p.out = (float*)d_out; p.ws = (unsigned char*)d_ws;
    (void)hipMemsetAsync(p.ws + WS_CTL, 0, CTL_BYTES, stream);
#if MK_PER_PHASE
    for (int ph = 0; ph < N_PHASES; ++ph) {
        const int kind = (ph == 0) ? 9 : (ph == N_PHASES - 1) ? 10 : (ph - 1) % 9;
        a.ph_lo = ph; a.ph_hi = ph + 1;
        if (kind == PROBE_DUP_KIND) { a.dry = 1; for (int r = 0; r < PROBE_DUP_N; ++r) hipLaunchKernelGGL(mk, dim3(grid), dim3(NTHR), LDS_BYTES, stream, a); }
        a.dry = 0; hipLaunchKernelGGL(mk, dim3(grid), dim3(NTHR), LDS_BYTES, stream, a); }
#else
    a.ph_lo = 0; a.ph_hi = N_PHASES;
    hipLaunchKernelGGL(mk, dim3(grid), dim3(NTHR), LDS_BYTES, stream, a);
#endif
}
```

```cpp
#include <hip/hip_runtime.h>
#include <stdint.h>
#include <stdio.h>

typedef unsigned short bf16;
typedef float f32x4 __attribute__((ext_vector_type(4)));
typedef unsigned u32x4 __attribute__((ext_vector_type(4)));
typedef unsigned u32x2 __attribute__((ext_vector_type(2)));
#define LAS __attribute__((address_space(3)))

constexpr int NB = 8, SEQ = 2048, DM = 1024, NL = 4, NTOK = NB * SEQ;
constexpr int GH = 4, GHK = 128, GHV = 256, GDK = 512, GDV = 1024, GCH = 64;
constexpr int SH = 16, SKV = 2, HD = 64, SDQ = 1024, SDKV = 128, WIN = 128;
constexpr int NE = 16, FE = 512;
constexpr int DIN = 6416, NMOD = 6144;
constexpr int C_QA = 0, C_KA = 512, C_VA = 1024, C_RA = 2048, C_LR = 3072, C_QB = 3088, C_KB = 4112, C_VB = 4240, C_GTA = 4368, C_GTB = 5392;
constexpr float EPS = 1e-6f;

constexpr size_t MiB = 1u << 20;
constexpr size_t WS_CTL = 0;
constexpr size_t WS_MOD = 1 * MiB;
constexpr size_t WS_ROPE = 2 * MiB;
constexpr size_t WS_RE = 6 * MiB;
constexpr size_t WS_RW = 6 * MiB + 256 * 1024;
constexpr size_t WS_RS = 6 * MiB + 512 * 1024;
constexpr size_t WS_ROWIDX = 7 * MiB;
constexpr size_t WS_LR = 8 * MiB;
constexpr size_t WS_DEC = 9 * MiB;
constexpr size_t WS_PLG = 10 * MiB;
constexpr size_t WS_X = 16 * MiB;
constexpr size_t WS_H = 80 * MiB;
constexpr size_t WS_QA = 112 * MiB;
constexpr size_t WS_KA = 128 * MiB;
constexpr size_t WS_GA = 144 * MiB;
constexpr size_t WS_VA = 176 * MiB;
constexpr size_t WS_RA = 208 * MiB;
constexpr size_t WS_QB = 240 * MiB;
constexpr size_t WS_KB = 272 * MiB;
constexpr size_t WS_VB = 276 * MiB;
constexpr size_t WS_GTA = 280 * MiB;
constexpr size_t WS_GTB = 312 * MiB;
constexpr size_t WS_OI = 344 * MiB;
constexpr size_t WS_HID = 112 * MiB;
constexpr size_t WS_Y = 150 * MiB;
constexpr size_t WS_W = 408 * MiB;
constexpr size_t WS_END = 680 * MiB;

constexpr int CW_CNT = 1024;
constexpr size_t CTL_BYTES = 1 * MiB;

__device__ __forceinline__ float bf2f(bf16 b) { return __uint_as_float(((unsigned)b) << 16); }
__device__ __forceinline__ bf16 f2bf(float f) { unsigned u = __float_as_uint(f); u += 0x7fffu + ((u >> 16) & 1u); return (bf16)(u >> 16); }
__device__ __forceinline__ unsigned pk2(float lo, float hi) { return (unsigned)f2bf(lo) | ((unsigned)f2bf(hi) << 16); }
__device__ __forceinline__ float lo16(unsigned u) { return __uint_as_float(u << 16); }
__device__ __forceinline__ float hi16(unsigned u) { return __uint_as_float(u & 0xffff0000u); }
__device__ __forceinline__ float wave_sum(float v) {
#pragma unroll
    for (int o = 1; o < 64; o <<= 1) v += __shfl_xor(v, o);
    return v;
}
__device__ __forceinline__ float shx(float v, int mask, int lane) { return __builtin_bit_cast(float, __builtin_amdgcn_ds_bpermute((lane ^ mask) << 2, __builtin_bit_cast(int, v))); }
__device__ __forceinline__ int shx_i(int v, int mask, int lane) { return __builtin_amdgcn_ds_bpermute((lane ^ mask) << 2, v); }
__device__ __forceinline__ int shl_from(int v, int src) { return __builtin_amdgcn_ds_bpermute(src << 2, v); }
__device__ __forceinline__ float wave_sum(float v, int lane) {
#pragma unroll
    for (int o = 1; o < 64; o <<= 1) v += shx(v, o, lane);
    return v;
}
__device__ __forceinline__ float wave_max(float v) {
#pragma unroll
    for (int o = 1; o < 64; o <<= 1) v = fmaxf(v, __shfl_xor(v, o));
    return v;
}
__device__ __forceinline__ float sigmoidf_(float x) { return __builtin_amdgcn_rcpf(1.f + __expf(-x)); }
__device__ __forceinline__ float siluf_(float x) { return x * __builtin_amdgcn_rcpf(1.f + __expf(-x)); }
__device__ __forceinline__ float logsigmoidf_(float x) { return fminf(x, 0.f) - log1pf(__expf(-fabsf(x))); }

struct P {
    const float *x, *c; const int* pos;
    const float *ada_w, *ada_b, *n1g, *n2g, *fg, *w_in, *aw, *ab, *glag, *sinks, *w_pa, *w_pb, *w_out, *rw, *rb, *wg, *wu, *wd;
    float* out; unsigned char* ws;
};

__device__ __forceinline__ void rope_entry(const int* pos, float2* tab, int idx) {
    const int tok = idx >> 5, j = idx & 31;
    double inv = 1.0; for (int i = 0; i < j; ++i) inv *= 0.74989420933245582;
    const double rev = (double)pos[tok] * inv * 0.15915494309189535;
    const float fr = (float)(rev - rint(rev));
    tab[idx] = make_float2(__builtin_amdgcn_cosf(fr), __builtin_amdgcn_sinf(fr));
}

__device__ __forceinline__ void row_load(const float* xin, int m, int lane, f32x4 (&v)[4]) {
#pragma unroll
    for (int j = 0; j < 4; ++j) v[j] = *(const f32x4*)(xin + (size_t)m * DM + 256 * j + 4 * lane);
}
__device__ __forceinline__ void token_row(const P& p, int l, int m, int lane, int mode, const f32x4 (&vin)[4], const float* ng, const float* sc, const float* sh, const float* g2prev, int startv,
                                          LAS int* re_lds  , float rpart = 0.f  , const LAS float* rbias = nullptr  ) {
    const int b = m >> 11;
    float* X = (float*)(p.ws + WS_X); bf16* H = (bf16*)(p.ws + WS_H);
    f32x4 v[4];
#pragma unroll
    for (int j = 0; j < 4; ++j) v[j] = vin[j];
    if (mode & 1) {
        const unsigned* RS = (const unsigned*)(p.ws + WS_RS); const float* RW = (const float*)(p.ws + WS_RW); const int* RE = (const int*)(p.ws + WS_RE);
        const float w0 = RW[2 * m], w1 = RW[2 * m + 1];
        int p0, p1;
        if (mode & 16) { p0 = shl_from(startv, RE[2 * m]) + (int)RS[2 * m]; p1 = shl_from(startv, RE[2 * m + 1]) + (int)RS[2 * m + 1]; }
        else { p0 = 2 * m; p1 = 2 * m + 1; }
        const bf16* Y = (const bf16*)(p.ws + WS_Y);
#pragma unroll
        for (int j = 0; j < 4; ++j) {
            const u32x2 a = *(const u32x2*)(Y + (size_t)p0 * DM + 256 * j + 4 * lane), c = *(const u32x2*)(Y + (size_t)p1 * DM + 256 * j + 4 * lane);
            const f32x4 g = *(const f32x4*)(g2prev + b * NMOD + 256 * j + 4 * lane);
            v[j].x += g.x * (w0 * lo16(a.x) + w1 * lo16(c.x)); v[j].y += g.y * (w0 * hi16(a.x) + w1 * hi16(c.x));
            v[j].z += g.z * (w0 * lo16(a.y) + w1 * lo16(c.y)); v[j].w += g.w * (w0 * hi16(a.y) + w1 * hi16(c.y));
        }
    }
    if ((mode & 2) && !(mode & 64)) {
#pragma unroll
        for (int j = 0; j < 4; ++j) *(f32x4*)(X + (size_t)m * DM + 256 * j + 4 * lane) = v[j];
    }
    float ss = 0.f;
#pragma unroll
    for (int j = 0; j < 4; ++j) ss += (v[j].x * v[j].x + v[j].y * v[j].y) + (v[j].z * v[j].z + v[j].w * v[j].w);
    ss = wave_sum(ss, lane);
    const float rstd = 1.0f / sqrtf(ss * (1.0f / DM) + EPS);
    if (mode & 4) {
#pragma unroll
        for (int j = 0; j < 4; ++j) { const f32x4 g = *(const f32x4*)(p.fg + 256 * j + 4 * lane); if (!(mode & 64)) *(f32x4*)(p.out + (size_t)m * DM + 256 * j + 4 * lane) = v[j] * rstd * g; }
        return;
    }
    f32x4 h[4];
#pragma unroll
    for (int j = 0; j < 4; ++j) {
        const f32x4 g = *(const f32x4*)(ng + 256 * j + 4 * lane), s1 = *(const f32x4*)(sc + b * NMOD + 256 * j + 4 * lane), s0 = *(const f32x4*)(sh + b * NMOD + 256 * j + 4 * lane);
        h[j] = v[j] * rstd * g * (1.0f + s1) + s0;
        u32x2 o; o.x = pk2(h[j].x, h[j].y); o.y = pk2(h[j].z, h[j].w);
        if (!(mode & 64)) *(u32x2*)(H + (size_t)m * DM + 256 * j + 4 * lane) = o;
    }
    if (mode & 8) {
        float scv[16], bi[16];
        {   const float lgv = rstd * rpart + rbias[lane & 15];
            const float scl = sigmoidf_(lgv), bil = scl + p.rb[lane & 15];
#pragma unroll
            for (int e = 0; e < 16; ++e) { scv[e] = __builtin_bit_cast(float, __builtin_amdgcn_readlane(__builtin_bit_cast(int, scl), e)); bi[e] = __builtin_bit_cast(float, __builtin_amdgcn_readlane(__builtin_bit_cast(int, bil), e)); } }
        float bestg = -1e30f; int e1 = 0, e2 = 1; float w1 = 0.f, w2 = 0.f;
#pragma unroll
        for (int g = 0; g < 4; ++g) {
            float m1 = -1e30f, m2 = -1e30f; int i1 = 0, i2 = 0; float s1 = 0.f, s2 = 0.f;
#pragma unroll
            for (int q = 0; q < 4; ++q) {
                const float vq = bi[4 * g + q];
                if (vq > m1) { m2 = m1; i2 = i1; s2 = s1; m1 = vq; i1 = 4 * g + q; s1 = scv[4 * g + q]; }
                else if (vq > m2) { m2 = vq; i2 = 4 * g + q; s2 = scv[4 * g + q]; }
            }
            const float gs = m1 + m2;
            if (gs > bestg) { bestg = gs; e1 = i1; e2 = i2; w1 = s1; w2 = s2; }
        }
        const float inv = 1.0f / (w1 + w2);
        if (lane == 0 && !(mode & 64)) {
            int* RE = (int*)(p.ws + WS_RE); float* RW = (float*)(p.ws + WS_RW);
            RE[2 * m] = e1; RE[2 * m + 1] = e2; RW[2 * m] = w1 * inv; RW[2 * m + 1] = w2 * inv;
            if (re_lds) { re_lds[0] = e1; re_lds[1] = e2; }
        }
        if (lane == 0 && (mode & 64) && re_lds) { re_lds[0] = e1; re_lds[1] = e2; }
    }
}
__device__ __forceinline__ int expert_start_lane(const unsigned* cnt, int lane) {
    int c = (lane < 16) ? (int)cnt[lane] : 0; c = (c + 255) & ~255;
    int s = c;
#pragma unroll
    for (int o = 1; o < 16; o <<= 1) { const int t = shl_from(s, lane - o); if ((lane & 15) >= o) s += t; }
    return s - c;
}

typedef short bf16x8 __attribute__((ext_vector_type(8)));
typedef short s16x4 __attribute__((ext_vector_type(4)));
typedef float f32x16 __attribute__((ext_vector_type(16)));
typedef __bf16 bf16x2_t __attribute__((ext_vector_type(2)));
typedef float f32x2_t __attribute__((ext_vector_type(2)));
__device__ __forceinline__ unsigned cvtpk(float lo, float hi) { f32x2_t v = {lo, hi}; bf16x2_t b = __builtin_convertvector(v, bf16x2_t); return __builtin_bit_cast(unsigned, b); }
#define MFMA32(a, b, c) __builtin_amdgcn_mfma_f32_32x32x16_bf16((a), (b), (c), 0, 0, 0)
__device__ __forceinline__ int crow(int reg, int h) { return (reg & 3) + 8 * (reg >> 2) + 4 * h; }
template <int S_> __device__ __forceinline__ bf16x8 pack_step(const f32x16& x) {
    u32x4 p; p.x = cvtpk(x[8 * S_], x[8 * S_ + 1]); p.y = cvtpk(x[8 * S_ + 2], x[8 * S_ + 3]); p.z = cvtpk(x[8 * S_ + 4], x[8 * S_ + 5]); p.w = cvtpk(x[8 * S_ + 6], x[8 * S_ + 7]);
    return __builtin_bit_cast(bf16x8, p);
}
__device__ __forceinline__ u32x4 pack8(const f32x4 a, const f32x4 b) { u32x4 w; w.x = cvtpk(a[0], a[1]); w.y = cvtpk(a[2], a[3]); w.z = cvtpk(b[0], b[1]); w.w = cvtpk(b[2], b[3]); return w; }

constexpr int NTHR = 512, NWAVES = 8;
constexpr int RING_BYTES = 135168;
constexpr int LX_OFF = RING_BYTES;
constexpr int LX_BAR = LX_OFF + 0;
constexpr int LX_TS = LX_OFF + 64;
constexpr int LX_CNT = LX_OFF + 192;
constexpr int LX_BASE = LX_OFF + 256;
constexpr int LX_RE = LX_OFF + 320;
constexpr int LX_RANK = LX_OFF + 832;
constexpr int LX_ROWS = LX_OFF + 2048;
constexpr int LDS_BYTES = RING_BYTES + 8192;

constexpr size_t WL_STRIDE = 68 * MiB, WL_IN = 0, WL_PA = 14 * MiB, WL_PB = 16 * MiB, WL_OUT = 18 * MiB, WL_GU = 20 * MiB, WL_D = 52 * MiB;
constexpr int NIN = 6912;
constexpr int T_QA = 0, T_KA = 2, T_GA = 4, T_VA = 6, T_RA = 10, T_QB = 14, T_KV = 18, T_GTA = 19, T_GTB = 23;

#define XB_TMO      128
#define XB_XCNT(j)  (256  + 64 * (j))
#define XB_XSUB(j)  (1280 + 64 * (j))
#define XB_XGEN(j)  (2304 + 64 * (j))
#define XB_TOP      3328
#define XB_TOPGEN   3392
#define XCD_BAR_WORDS 3456
#define XB_SPIN_CAP (1u << 18)
constexpr int CW_BAR = 8192;
__device__ __forceinline__ unsigned xb_ld(unsigned* p)              { return __hip_atomic_load(p, __ATOMIC_RELAXED, __HIP_MEMORY_SCOPE_AGENT); }
__device__ __forceinline__ unsigned xb_add(unsigned* p, unsigned v) { return __hip_atomic_fetch_add(p, v, __ATOMIC_RELAXED, __HIP_MEMORY_SCOPE_AGENT); }
__device__ __forceinline__ unsigned xb_xcc_id() { return (unsigned)__builtin_amdgcn_s_getreg((3 << 11) | 20) & 0xFu; }
#define XB_SPIN(cond, bar) do { unsigned _sp = 0; while (cond) { __builtin_amdgcn_s_sleep(1); \
    if ((++_sp & 255u) == 0u) { if (xb_ld(&(bar)[XB_TMO])) break; if (_sp > XB_SPIN_CAP) { atomicAdd(&(bar)[XB_TMO], 1u); break; } } } } while (0)
struct XcdBarrier { unsigned* bar; unsigned x; volatile LAS unsigned* st; };
__device__ __forceinline__ XcdBarrier xcd_barrier_post(unsigned* bar, volatile LAS unsigned* st) {
    XcdBarrier b; b.bar = bar; b.x = xb_xcc_id(); b.st = st;
    if (threadIdx.x == 0) (void)xb_add(&bar[XB_XCNT(b.x)], 1u);
    return b;
}
__device__ __forceinline__ void xcd_barrier_complete(unsigned* bar, unsigned x, unsigned& nloc, unsigned& nx) {
    const unsigned G = gridDim.x * gridDim.y * gridDim.z;
    unsigned sum, cnt, mine, sp = 0u;
    for (;;) {
        sum = 0u; cnt = 0u; mine = 0u;
#pragma unroll
        for (unsigned j = 0; j < 16; ++j) { const unsigned c = xb_ld(&bar[XB_XCNT(j)]); sum += c; cnt += (c > 0u) ? 1u : 0u; mine = (j == x) ? c : mine; }
        if (sum == G) break;
        __builtin_amdgcn_s_sleep(1);
        if ((++sp & 255u) == 0u) { if (xb_ld(&bar[XB_TMO])) break; if (sp > XB_SPIN_CAP) { atomicAdd(&bar[XB_TMO], 1u); break; } }
    }
    nloc = mine > 0u ? mine : 1u; nx = cnt > 0u ? cnt : 1u;
}
__device__ __forceinline__ void xcd_barrier(const XcdBarrier& b) {
    asm volatile("s_waitcnt vmcnt(0)" ::: "memory");
    __syncthreads();
    if (threadIdx.x == 0) {
        unsigned* bar = b.bar;
        __builtin_amdgcn_s_waitcnt(0);
        unsigned nloc = b.st[0], nx = b.st[1];
        if (nloc == 0u) { xcd_barrier_complete(bar, b.x, nloc, nx); b.st[0] = nloc; b.st[1] = nx; }
        const unsigned old = xb_add(&bar[XB_XSUB(b.x)], 1u);
        const unsigned gen = old / nloc;
        if (old + 1u == (gen + 1u) * nloc) {
            __builtin_amdgcn_fence(__ATOMIC_RELEASE, "agent");
            asm volatile("s_waitcnt vmcnt(0)" ::: "memory");
            const unsigned og = xb_add(&bar[XB_TOP], 1u);
            const unsigned tg = og / nx;
            if (og + 1u == (tg + 1u) * nx) xb_add(&bar[XB_TOPGEN], 1u);
            else XB_SPIN(xb_ld(&bar[XB_TOPGEN]) == tg, bar);
            __builtin_amdgcn_fence(__ATOMIC_ACQUIRE, "agent");
            xb_add(&bar[XB_XGEN(b.x)], 1u);
            asm volatile("s_waitcnt vmcnt(0)" ::: "memory");
        } else {
            XB_SPIN(xb_ld(&bar[XB_XGEN(b.x)]) == gen, bar);
            __builtin_amdgcn_fence(__ATOMIC_ACQUIRE, "agent");
            asm volatile("s_waitcnt vmcnt(0)" ::: "memory");
        }
    }
    __syncthreads();
}

namespace pg8 {
constexpr int BM = 256, BK = 64, HALF = 128, HTB = HALF * BK * 2, STAGE_BYTES = 8 * HTB, NXCD = 8, WGM = 8;
__device__ __forceinline__ int lds_byte(int r, int c) { const int st = (r >> 4) * 2 + (c >> 5), rr = r & 15, cc = c & 31, ob = rr * 64 + cc * 2; return st * 1024 + (ob ^ (((ob >> 9) & 1) << 5)); }
__device__ __forceinline__ void stage_rc(int b, int& R, int& C) { const int st = b / 1024, sb = b % 1024, swz = sb ^ (((sb >> 9) & 1) << 5); R = (st >> 1) * 16 + swz / 64; C = (st & 1) * 32 + (swz % 64) / 2; }
__device__ __forceinline__ int perm32(int rho) { const int n = rho >> 4, i = rho & 15; return 8 * (i >> 2) + 4 * n + (i & 3); }
struct Unit { int pm, pn, z, e; const char* a; const char* b; };

template <class Epi, class Sched, bool GATHER>
__device__ __forceinline__ void gemm_phase(LAS unsigned char* lds, const int tid, const int K, const Sched& S, const Epi& E) {
    const int wid = __builtin_amdgcn_readfirstlane(tid >> 6), lane = tid & 63, wr = wid >> 2, wc = wid & 3, fr = lane & 15, fq = lane >> 4;
    const int nt = K / BK;
    unsigned voffA[2], voffB[2];
#pragma unroll
    for (int i = 0; i < 2; ++i) { int R, C; stage_rc(tid * 16 + i * 8192, R, C); const int Rb = Epi::PERM ? ((R & ~31) + perm32(R & 31)) : R;
        voffA[i] = (unsigned)(R * K + C) * 2u; voffB[i] = (unsigned)(Rb * K + C) * 2u; }
    unsigned gA[2][2], gN[2][2];
    const size_t kstep = (size_t)(BK * 2);
    const size_t hstep = (size_t)HALF * K * 2;
    const unsigned ldsw = (unsigned)wid * 1024u;
    const int aoff = lds_byte(wr * 64 + fr, fq * 8), boff = lds_byte(wc * 32 + fr, fq * 8);
#define PG8_SA(b, h) (((b) * 2 + (h)) * HTB)
#define PG8_SB(b, h) ((4 + (b) * 2 + (h)) * HTB)
#define PG8_STAGE_B(bufoff, gbase) do { _Pragma("unroll") for (int _i = 0; _i < 2; ++_i) \
        __builtin_amdgcn_global_load_lds((const unsigned*)((const char*)(gbase) + voffB[_i]), (LAS unsigned*)(lds + (bufoff) + ldsw + _i * 8192), 16, 0, 0); } while (0)
#define PG8_STAGE_A(bufoff, gbase, h, G) do { _Pragma("unroll") for (int _i = 0; _i < 2; ++_i) { \
        const char* _p = GATHER ? ((const char*)(gbase) + G[h][_i]) : ((const char*)(gbase) + (size_t)(h) * hstep + voffA[_i]); \
        __builtin_amdgcn_global_load_lds((const unsigned*)_p, (LAS unsigned*)(lds + (bufoff) + ldsw + _i * 8192), 16, 0, 0); } } while (0)
#define PG8_LDA(dst, b, h) do { _Pragma("unroll") for (int m = 0; m < 4; ++m) _Pragma("unroll") for (int k = 0; k < 2; ++k) dst[m][k] = *(const LAS bf16x8*)(lds + PG8_SA(b, h) + aoff + m * 2048 + k * 1024); } while (0)
#define PG8_LDB(dst, b, h) do { _Pragma("unroll") for (int n = 0; n < 2; ++n) _Pragma("unroll") for (int k = 0; k < 2; ++k) dst[n][k] = *(const LAS bf16x8*)(lds + PG8_SB(b, h) + boff + n * 2048 + k * 1024); } while (0)
#define PG8_MMA(ai, bj, At, Bt) do { __builtin_amdgcn_s_setprio(1); _Pragma("unroll") for (int m = 0; m < 4; ++m) _Pragma("unroll") for (int n = 0; n < 2; ++n) _Pragma("unroll") for (int k = 0; k < 2; ++k) \
        acc[ai][bj][m][n] = __builtin_amdgcn_mfma_f32_16x16x32_bf16(Bt[n][k], At[m][k], acc[ai][bj][m][n], 0, 0, 0); __builtin_amdgcn_s_setprio(0); } while (0)
#define PG8_WAIT_V(n) asm volatile("s_waitcnt vmcnt(" #n ")" ::: "memory")
#define PG8_WAIT_L(n) asm volatile("s_waitcnt lgkmcnt(" #n ")" ::: "memory")
#define PG8_BAR __builtin_amdgcn_s_barrier()
#define PG8_SCHED __builtin_amdgcn_sched_barrier(0)
    Unit cur, nxt; int ui = 0;
    if (!S.next(0, cur)) return;
    f32x4 acc[2][2][4][2];
#pragma unroll
    for (int a = 0; a < 2; ++a)
#pragma unroll
        for (int b = 0; b < 2; ++b)
#pragma unroll
            for (int m = 0; m < 4; ++m)
#pragma unroll
                for (int n = 0; n < 2; ++n) acc[a][b][m][n] = (f32x4){0.f, 0.f, 0.f, 0.f};
    bf16x8 At[4][2], B0[2][2], B1[2][2];
    if constexpr (GATHER) S.rows(0, K, tid, gA);
    const char* cA = cur.a; const char* cB = cur.b;
    PG8_STAGE_B(PG8_SB(0, 0), cB); PG8_STAGE_B(PG8_SB(0, 1), cB + hstep); PG8_STAGE_A(PG8_SA(0, 0), cA, 0, gA); PG8_STAGE_A(PG8_SA(0, 1), cA, 1, gA);
    if (wr == 1) PG8_BAR;
    PG8_WAIT_V(2); PG8_BAR;
    PG8_STAGE_B(PG8_SB(1, 0), cB + kstep); PG8_STAGE_A(PG8_SA(1, 0), cA + kstep, 0, gA); PG8_STAGE_B(PG8_SB(1, 1), cB + hstep + kstep);
    PG8_WAIT_V(6); PG8_BAR;
    for (;;) {
        const bool has_next = S.next(ui + 1, nxt);
        const char* nA = has_next ? nxt.a : cA; const char* nB = has_next ? nxt.b : cB;
        if constexpr (GATHER) { if (has_next) S.rows(ui + 1, K, tid, gN); else { gN[0][0] = gA[0][0]; gN[0][1] = gA[0][1]; gN[1][0] = gA[1][0]; gN[1][1] = gA[1][1]; } }
        for (int t = 0; t < nt; t += 2) {
            const bool last = (t == nt - 2);
            const char* a1 = cA + (size_t)(t + 1) * kstep;
            const char* a2 = last ? nA : cA + (size_t)(t + 2) * kstep; const char* b2 = last ? nB : cB + (size_t)(t + 2) * kstep;
            const char* a3 = a2 + kstep; const char* b3 = b2 + kstep;
            unsigned g2[2][2];
            if constexpr (GATHER) { g2[0][0] = last ? gN[0][0] : gA[0][0]; g2[0][1] = last ? gN[0][1] : gA[0][1]; g2[1][0] = last ? gN[1][0] : gA[1][0]; g2[1][1] = last ? gN[1][1] : gA[1][1]; }
            PG8_LDB(B0, 0, 0); PG8_LDB(B1, 0, 1); PG8_SCHED; PG8_LDA(At, 0, 0); PG8_STAGE_A(PG8_SA(1, 1), a1, 1, gA);
            PG8_WAIT_V(8); PG8_WAIT_L(0); PG8_BAR; PG8_MMA(0, 0, At, B0); PG8_MMA(0, 1, At, B1); PG8_BAR; PG8_SCHED;
            PG8_LDA(At, 0, 1); PG8_STAGE_B(PG8_SB(0, 0), b2); PG8_STAGE_B(PG8_SB(0, 1), b2 + hstep); PG8_STAGE_A(PG8_SA(0, 0), a2, 0, g2);
            PG8_WAIT_V(8); PG8_WAIT_L(0); PG8_BAR; PG8_MMA(1, 0, At, B0); PG8_MMA(1, 1, At, B1); PG8_BAR; PG8_SCHED;
            PG8_LDB(B0, 1, 0); PG8_LDB(B1, 1, 1); PG8_SCHED; PG8_LDA(At, 1, 0); PG8_STAGE_A(PG8_SA(0, 1), a2, 1, g2);
            PG8_WAIT_V(8); PG8_WAIT_L(0); PG8_BAR; PG8_MMA(0, 0, At, B0); PG8_MMA(0, 1, At, B1); PG8_BAR; PG8_SCHED;
            PG8_LDA(At, 1, 1); PG8_STAGE_B(PG8_SB(1, 0), b3); PG8_STAGE_B(PG8_SB(1, 1), b3 + hstep); PG8_STAGE_A(PG8_SA(1, 0), a3, 0, g2);
            PG8_WAIT_V(8); PG8_WAIT_L(0); PG8_BAR; PG8_MMA(1, 0, At, B0); PG8_MMA(1, 1, At, B1); PG8_BAR; PG8_SCHED;
        }
        if (wr == 0) PG8_BAR;
        if constexpr (!Epi::AFTER_DRAIN) E(acc, cur, wr, wc, fr, fq);
        if (!has_next) break;
        if (!(Epi::CHAIN && cur.z == 0))
#pragma unroll
        for (int a = 0; a < 2; ++a)
#pragma unroll
            for (int b = 0; b < 2; ++b)
#pragma unroll
                for (int m = 0; m < 4; ++m)
#pragma unroll
                    for (int n = 0; n < 2; ++n) acc[a][b][m][n] = (f32x4){0.f, 0.f, 0.f, 0.f};
        cur = nxt; cA = nA; cB = nB; ++ui;
        if constexpr (GATHER) { gA[0][0] = gN[0][0]; gA[0][1] = gN[0][1]; gA[1][0] = gN[1][0]; gA[1][1] = gN[1][1]; }
        if (wr == 1) PG8_BAR;
    }
    PG8_WAIT_V(0);
    PG8_BAR;
    if constexpr (Epi::AFTER_DRAIN) E.fused(acc, cur, wr, wc, fr, fq, lds, tid);
#undef PG8_SA
#undef PG8_SB
#undef PG8_STAGE_A
#undef PG8_STAGE_B
#undef PG8_LDA
#undef PG8_LDB
#undef PG8_MMA
#undef PG8_WAIT_V
#undef PG8_WAIT_L
#undef PG8_BAR
#undef PG8_SCHED
}

__device__ __forceinline__ bool static_tile(int L, int nM, int nN, int& pm, int& pn) {
    const int nwg = nM * nN; if (L >= nwg) return false;
    int wgid = L; { const int q = nwg / NXCD, r = nwg % NXCD, xcd = wgid % NXCD, off = wgid / NXCD; wgid = (xcd < r ? xcd * (q + 1) : r * (q + 1) + (xcd - r) * q) + off; }
    const int nig = WGM * nN, gid = wgid / nig, fm = gid * WGM, gsz = (nM - fm) < WGM ? (nM - fm) : WGM;
    pm = fm + ((wgid % nig) % gsz); pn = (wgid % nig) / gsz; return true;
}
struct SchedStatic {
    int nM, nN, G, c; const char* A; const char* B; size_t ta, tb;
    __device__ __forceinline__ bool next(int i, Unit& u) const {
        int pm, pn; if (!static_tile(i * G + c, nM, nN, pm, pn)) return false;
        u.pm = pm; u.pn = pn; u.z = 0; u.e = 0; u.a = A + (size_t)pm * ta; u.b = B + (size_t)pn * tb; return true; }
};
struct SchedPair {
    int nM, nN, G, c; const char* A0; const char* B0; const char* A1; const char* B1; size_t ta, tb;
    __device__ __forceinline__ bool next(int i, Unit& u) const {
        int pm, pn; if (!static_tile((i >> 1) * G + c, nM, nN, pm, pn)) return false;
        u.pm = pm; u.pn = pn; u.z = i & 1; u.e = 0; u.a = ((i & 1) ? A1 : A0) + (size_t)pm * ta; u.b = ((i & 1) ? B1 : B0) + (size_t)pn * tb; return true; }
};
struct SchedMoe {
    int G, c; const LAS int* ts; const LAS unsigned* rowtab; const char* A; const char* B; size_t ta, tbe, tbt;
    __device__ __forceinline__ bool next(int i, Unit& u) const {
        const int L = i * G + c; if (L >= 4 * ts[16]) return false;
        const int rt = L >> 2, pn = L & 3; int e = 0;
#pragma unroll
        for (int q = 1; q < 16; ++q) e += (rt >= ts[q]) ? 1 : 0;
        u.pm = rt; u.pn = pn; u.z = 0; u.e = e; u.a = A + (size_t)rt * ta; u.b = B + (size_t)e * tbe + (size_t)pn * tbt; return true; }
    __device__ __forceinline__ void rows(int i, int K, int tid, unsigned (&g)[2][2]) const {
#pragma unroll
        for (int p = 0; p < 2; ++p) { int R, C; stage_rc(tid * 16 + p * 8192, R, C);
            g[0][p] = rowtab[i * 256 + R] + (unsigned)C * 2u; g[1][p] = rowtab[i * 256 + 128 + R] + (unsigned)C * 2u; }
    }
};
}
using pg8::Unit;
__device__ __forceinline__ f32x4 silu4(f32x4 v) { f32x4 r; r[0] = siluf_(v[0]); r[1] = siluf_(v[1]); r[2] = siluf_(v[2]); r[3] = siluf_(v[3]); return r; }
__device__ __forceinline__ f32x4 sigm4(f32x4 v) { f32x4 r; r[0] = sigmoidf_(v[0]); r[1] = sigmoidf_(v[1]); r[2] = sigmoidf_(v[2]); r[3] = sigmoidf_(v[3]); return r; }
__device__ __forceinline__ f32x4 bflo4(u32x2 w) { return (f32x4){lo16(w.x), hi16(w.x), lo16(w.y), hi16(w.y)}; }

#ifndef EPI_NT
#define EPI_NT 1
#endif
#if EPI_NT
#define EPI_ST16(p_, v_) __builtin_nontemporal_store((v_), (u32x4*)(p_))
#define EPI_ST16F(p_, v_) __builtin_nontemporal_store((v_), (f32x4*)(p_))
#else
#define EPI_ST16(p_, v_) (*(u32x4*)(p_) = (v_))
#define EPI_ST16F(p_, v_) (*(f32x4*)(p_) = (v_))
#endif
struct EpiInProj {
    static constexpr bool PERM = true, CHAIN = false, AFTER_DRAIN = false;
    unsigned char* ws; const float* ab; bool skip, nost;
    template <int KIND> __device__ __forceinline__ void run(const f32x4 (&acc)[2][2][4][2], const Unit& u, int wr, int wc, int fr, int fq) const {
        const int pn = u.pn;
#pragma unroll
        for (int ai = 0; ai < 2; ++ai)
#pragma unroll
            for (int m = 0; m < 4; ++m) {
                const int row = u.pm * 256 + ai * 128 + wr * 64 + m * 16 + fr, b = row >> 11, s = row & 2047;
#pragma unroll
                for (int bj = 0; bj < 2; ++bj) {
                    const int c8 = bj * 128 + wc * 32 + 8 * fq;
                    const f32x4 v0 = acc[ai][bj][m][0], v1 = acc[ai][bj][m][1];
                    if (KIND == 0) {
                        const int cc = (pn & 1) * 256 + c8, h = cc >> 7, d = cc & 127;
                        bf16* dst = (bf16*)(ws + (pn < T_KA ? WS_QA : WS_KA)) + ((size_t)(b * 4 + h) * SEQ + s) * 128 + d;
                        if (!nost) EPI_ST16(dst, pack8(v0, v1));
                    } else if (KIND == 1) {
                        const int cc = (pn - T_GA) * 256 + c8, h = cc >> 7, d = cc & 127;
                        const f32x4 b0 = *(const f32x4*)(ab + cc), b1 = *(const f32x4*)(ab + cc + 4);
                        f32x4 g0, g1;
#pragma unroll
                        for (int q = 0; q < 4; ++q) { const float x0 = v0[q] + b0[q], x1 = v1[q] + b1[q];
                            g0[q] = (fminf(x0, 0.f) - __logf(1.0f + __expf(-fabsf(x0)))) * 0.0625f; g1[q] = (fminf(x1, 0.f) - __logf(1.0f + __expf(-fabsf(x1)))) * 0.0625f; }
                        float* dst = (float*)(ws + WS_GA) + ((size_t)(b * 4 + h) * SEQ + s) * 128 + d;
                        if (!nost) { EPI_ST16F(dst, g0); EPI_ST16F(dst + 4, g1); }
                    } else if (KIND == 2) {
                        const int h = pn - T_VA;
                        bf16* dst = (bf16*)(ws + WS_VA) + ((size_t)(b * 4 + h) * SEQ + s) * 256 + c8;
                        if (!nost) EPI_ST16(dst, pack8(v0, v1));
                    } else if (KIND == 3) {
                        bf16* dst = (bf16*)(ws + WS_RA) + (size_t)row * 1024 + (pn - T_RA) * 256 + c8;
                        if (!nost) EPI_ST16(dst, pack8(silu4(v0), silu4(v1)));
                    } else if (KIND == 4) {
                        if (pn == T_KV && bj == 1) {
                            bf16* dst = (bf16*)(ws + WS_VB) + (size_t)row * 128 + (c8 - 128);
                            if (!nost) EPI_ST16(dst, pack8(v0, v1));
                        } else {
                            const int j0 = (c8 & 63) >> 1;
                            const f32x4* tab = (const f32x4*)((const float2*)(ws + WS_ROPE) + (size_t)row * 32 + j0);
                            const f32x4 t0 = tab[0], t1 = tab[1];
                            const float sc = (pn == T_KV) ? 1.0f : 0.125f;
                            f32x4 o0, o1;
                            o0[0] = (v0[0] * t0[0] - v0[1] * t0[1]) * sc; o0[1] = (v0[1] * t0[0] + v0[0] * t0[1]) * sc;
                            o0[2] = (v0[2] * t0[2] - v0[3] * t0[3]) * sc; o0[3] = (v0[3] * t0[2] + v0[2] * t0[3]) * sc;
                            o1[0] = (v1[0] * t1[0] - v1[1] * t1[1]) * sc; o1[1] = (v1[1] * t1[0] + v1[0] * t1[1]) * sc;
                            o1[2] = (v1[2] * t1[2] - v1[3] * t1[3]) * sc; o1[3] = (v1[3] * t1[2] + v1[2] * t1[3]) * sc;
                            bf16* dst = (pn == T_KV) ? (bf16*)(ws + WS_KB) + (size_t)row * 128 + c8 : (bf16*)(ws + WS_QB) + (size_t)row * 1024 + (pn - T_QB) * 256 + c8;
                            if (!nost) EPI_ST16(dst, pack8(o0, o1));
                        }
                    } else {
                        bf16* dst = (pn < T_GTB) ? (bf16*)(ws + WS_GTA) + (size_t)row * 1024 + (pn - T_GTA) * 256 + c8 : (bf16*)(ws + WS_GTB) + (size_t)row * 1024 + (pn - T_GTB) * 256 + c8;
                        if (!nost) EPI_ST16(dst, pack8(sigm4(v0), sigm4(v1)));
                    }
                }
                asm volatile("" ::: "memory");
            }
    }
    __device__ __forceinline__ void operator()(const f32x4 (&acc)[2][2][4][2], const Unit& u, int wr, int wc, int fr, int fq) const {
        const int pn = u.pn;
        if (skip) return;
        if (pn < T_GA) run<0>(acc, u, wr, wc, fr, fq);
        else if (pn < T_VA) run<1>(acc, u, wr, wc, fr, fq);
        else if (pn < T_RA) run<2>(acc, u, wr, wc, fr, fq);
        else if (pn < T_QB) run<3>(acc, u, wr, wc, fr, fq);
        else if (pn < T_GTA) run<4>(acc, u, wr, wc, fr, fq);
        else run<5>(acc, u, wr, wc, fr, fq);
    }
};
struct EpiMerge {
    static constexpr bool PERM = true, CHAIN = true, AFTER_DRAIN = false;
    unsigned char* ws;
    __device__ __forceinline__ void operator()(f32x4 (&acc)[2][2][4][2], const Unit& u, int wr, int wc, int fr, int fq) const {
#pragma unroll
        for (int ai = 0; ai < 2; ++ai)
#pragma unroll
            for (int m = 0; m < 4; ++m) {
                const int row = u.pm * 256 + ai * 128 + wr * 64 + m * 16 + fr;
#pragma unroll
                for (int bj = 0; bj < 2; ++bj) {
                    const size_t off = (size_t)row * 1024 + u.pn * 256 + bj * 128 + wc * 32 + 8 * fq;
                    const u32x4 gb = *(const u32x4*)((const bf16*)(ws + WS_GTB) + off);
                    f32x4 b0 = bflo4((u32x2){gb.x, gb.y}), b1 = bflo4((u32x2){gb.z, gb.w});
#pragma unroll
                    for (int q = 0; q < 4; ++q) { b0[q] = fmaxf(b0[q], 1e-20f); b1[q] = fmaxf(b1[q], 1e-20f); }
                    if (u.z == 0) {
                        const u32x4 ga = *(const u32x4*)((const bf16*)(ws + WS_GTA) + off);
                        const f32x4 a0 = bflo4((u32x2){ga.x, ga.y}), a1 = bflo4((u32x2){ga.z, ga.w});
#pragma unroll
                        for (int q = 0; q < 4; ++q) { acc[ai][bj][m][0][q] *= a0[q] * __builtin_amdgcn_rcpf(b0[q]); acc[ai][bj][m][1][q] *= a1[q] * __builtin_amdgcn_rcpf(b1[q]); }
                    } else {
                        *(u32x4*)((bf16*)(ws + WS_H) + off) = pack8(acc[ai][bj][m][0] * b0, acc[ai][bj][m][1] * b1);
                    }
                }
            }
    }
};
struct EpiResid {
    static constexpr bool PERM = false, CHAIN = false, AFTER_DRAIN = true;
    float* X; const float* g1; const float* n2g; const float* sc2; const float* rw; float* PLG; bool st;
    __device__ __forceinline__ void fused(const f32x4 (&acc)[2][2][4][2], const Unit& u, int wr, int wc, int fr, int fq, LAS unsigned char* lds, int tid) const {
        LAS float* rwp = (LAS float*)lds;
        LAS float* red = (LAS float*)(lds + 16384);
        const int bb = u.pm >> 3;
        {   const int c = tid >> 1, e0 = (tid & 1) * 8, cg = u.pn * 256 + c;
            const float sc = n2g[cg] * (1.0f + sc2[bb * NMOD + cg]);
            const f32x4 r0 = *(const f32x4*)(rw + cg * 16 + e0), r1 = *(const f32x4*)(rw + cg * 16 + e0 + 4);
            *(LAS f32x4*)(rwp + c * 16 + e0) = r0 * sc; *(LAS f32x4*)(rwp + c * 16 + e0 + 4) = r1 * sc; }
        asm volatile("s_waitcnt lgkmcnt(0)" ::: "memory"); __builtin_amdgcn_s_barrier(); asm volatile("" ::: "memory");
#pragma unroll
        for (int ai = 0; ai < 2; ++ai)
#pragma unroll
            for (int m = 0; m < 4; ++m) {
                const int rl = ai * 128 + wr * 64 + m * 16, row = u.pm * 256 + rl + fr;
                f32x4 lg = {0.f, 0.f, 0.f, 0.f};
#pragma unroll
                for (int bj = 0; bj < 2; ++bj)
#pragma unroll
                    for (int n = 0; n < 2; ++n) {
                        const int cl = bj * 128 + wc * 32 + n * 16 + 4 * fq, col = u.pn * 256 + cl;
                        float* xp = X + (size_t)row * 1024 + col;
                        const f32x4 g = *(const f32x4*)(g1 + bb * NMOD + col);
                        const f32x4 nv = *(const f32x4*)xp + g * acc[ai][bj][m][n]; if (st) *(f32x4*)xp = nv;
#pragma unroll
                        for (int q = 0; q < 4; ++q) lg = __builtin_amdgcn_mfma_f32_16x16x4f32(nv[q], rwp[(cl + q) * 16 + fr], lg, 0, 0, 0);
                    }
#pragma unroll
                for (int rg = 0; rg < 4; ++rg) red[(wc * 256 + rl + 4 * fq + rg) * 16 + fr] = lg[rg];
            }
        asm volatile("s_waitcnt lgkmcnt(0)" ::: "memory"); __builtin_amdgcn_s_barrier(); asm volatile("" ::: "memory");
#pragma unroll
        for (int j = 0; j < 2; ++j) { const int idx = tid + 512 * j;
            const f32x4 a0 = *(const LAS f32x4*)(red + idx * 4), a1 = *(const LAS f32x4*)(red + 4096 + idx * 4), a2 = *(const LAS f32x4*)(red + 8192 + idx * 4), a3 = *(const LAS f32x4*)(red + 12288 + idx * 4);
            const f32x4 sm = (a0 + a1) + (a2 + a3);
            if (st) *(f32x4*)(PLG + ((size_t)u.pn * NTOK + u.pm * 256) * 16 + idx * 4) = sm; }
    }
    __device__ __forceinline__ void operator()(const f32x4 (&)[2][2][4][2], const Unit&, int, int, int, int) const {}
};
struct EpiMoeUp {
    static constexpr bool PERM = true, CHAIN = false, AFTER_DRAIN = false;
    bf16* HID;
    __device__ __forceinline__ void operator()(const f32x4 (&acc)[2][2][4][2], const Unit& u, int wr, int wc, int fr, int fq) const {
#pragma unroll
        for (int ai = 0; ai < 2; ++ai)
#pragma unroll
            for (int m = 0; m < 4; ++m) {
                const int row = u.pm * 256 + ai * 128 + wr * 64 + m * 16 + fr;
#pragma unroll
                for (int bj = 0; bj < 2; ++bj) {
                    const int f = (u.pn * 256 + bj * 128 + wc * 32 + 8 * fq) >> 1;
                    const f32x4 hv = silu4(acc[ai][bj][m][0]) * acc[ai][bj][m][1];
                    u32x2 w; w.x = cvtpk(hv[0], hv[1]); w.y = cvtpk(hv[2], hv[3]);
                    *(u32x2*)(HID + (size_t)row * 512 + f) = w;
                }
            }
    }
};
struct EpiMoeDown {
    static constexpr bool PERM = true, CHAIN = false, AFTER_DRAIN = false;
    bf16* Y;
    __device__ __forceinline__ void operator()(const f32x4 (&acc)[2][2][4][2], const Unit& u, int wr, int wc, int fr, int fq) const {
#pragma unroll
        for (int ai = 0; ai < 2; ++ai)
#pragma unroll
            for (int m = 0; m < 4; ++m) {
                const int row = u.pm * 256 + ai * 128 + wr * 64 + m * 16 + fr;
#pragma unroll
                for (int bj = 0; bj < 2; ++bj)
                    *(u32x4*)(Y + (size_t)row * 1024 + u.pn * 256 + bj * 128 + wc * 32 + 8 * fq) = pack8(acc[ai][bj][m][0], acc[ai][bj][m][1]);
            }
    }
};
#define VM_WAIT() asm volatile("s_waitcnt vmcnt(0)" ::: "memory")
#define LDS_WAIT() asm volatile("s_waitcnt lgkmcnt(0)" ::: "memory")

__device__ __forceinline__ void conv_item(const float* cp, int ldw, bool fold, const float* aw_col, int Kdst, bf16* WT, int n0, int k0, LAS float* scr, int lane) {
    float v[32];
    if (!fold) {
#pragma unroll
        for (int i = 0; i < 32; ++i) v[i] = cp[(size_t)(k0 + 2 * i + (lane >> 5)) * ldw];
    } else {
        float aw[16];
#pragma unroll
        for (int r = 0; r < 16; ++r) aw[r] = aw_col[r * 512];
#pragma unroll
        for (int i = 0; i < 32; ++i) { const f32x4* lr = (const f32x4*)(cp + (size_t)(k0 + 2 * i + (lane >> 5)) * ldw); float a = 0.f;
#pragma unroll
            for (int q = 0; q < 4; ++q) { const f32x4 t = lr[q]; a += t[0] * aw[4 * q] + t[1] * aw[4 * q + 1] + t[2] * aw[4 * q + 2] + t[3] * aw[4 * q + 3]; }
            v[i] = a; }
    }
#pragma unroll
    for (int i = 0; i < 32; ++i) scr[(2 * i + (lane >> 5)) * 33 + (lane & 31)] = v[i];
    LDS_WAIT(); asm volatile("" ::: "memory");
    const int c = lane & 7;
#pragma unroll
    for (int j = 0; j < 4; ++j) { const int n = (lane >> 3) + 8 * j; const LAS float* s = scr + (8 * c) * 33 + n;
        u32x4 o; o.x = cvtpk(s[0 * 33], s[1 * 33]); o.y = cvtpk(s[2 * 33], s[3 * 33]); o.z = cvtpk(s[4 * 33], s[5 * 33]); o.w = cvtpk(s[6 * 33], s[7 * 33]);
        *(u32x4*)(WT + (size_t)(n0 + n) * Kdst + k0 + 8 * c) = o; }
    LDS_WAIT(); asm volatile("" ::: "memory");
}
constexpr int IT_IN = 16 * 216, IT_SQ = 16 * 32, IT_GU = 16 * 512, IT_D = 16 * 256, IT_LAYER = IT_IN + 3 * IT_SQ + IT_GU + IT_D;
__device__ __forceinline__ void conv_layer_item(const P& p, int l, int r, LAS float* scr, int lane) {
    {
        const int nl = lane & 31;
        unsigned char* wl = p.ws + WS_W + (size_t)l * WL_STRIDE;
        if (r < IT_IN) {
            const int kb = r / 216, nb = r % 216, n0 = 32 * nb, np = n0 + nl; const float* W = p.w_in + (size_t)l * 1024 * DIN;
            int col; bool fold = false;
            if (np < 512) col = C_QA + np; else if (np < 1024) col = C_KA + np - 512; else if (np < 1536) { fold = true; col = C_LR; }
            else if (np < 2560) col = C_VA + np - 1536; else if (np < 3584) col = C_RA + np - 2560;
            else if (np < 4608) { const int q = np - 3584, pp = q & 63; col = C_QB + (q >> 6) * 64 + (pp >> 1) + 32 * (pp & 1); }
            else if (np < 4736) { const int q = np - 4608, pp = q & 63; col = C_KB + (q >> 6) * 64 + (pp >> 1) + 32 * (pp & 1); }
            else if (np < 4864) col = C_VB + np - 4736; else if (np < 5888) col = C_GTA + np - 4864; else col = C_GTB + np - 5888;
            conv_item(W + col, DIN, fold, p.aw + (size_t)l * 16 * 512 + (np - 1024), 1024, (bf16*)(wl + WL_IN), n0, 64 * kb, scr, lane);
            return;
        }
        r -= IT_IN;
        if (r < 3 * IT_SQ) {
            const int which = r / IT_SQ, rr = r % IT_SQ, kb = rr / 32, nb = rr % 32;
            const float* wsel0 = p.w_pa; const float* wsel1 = p.w_pb; const float* wsel2 = p.w_out;
            asm volatile("" : "+s"(wsel0), "+s"(wsel1), "+s"(wsel2));
            const float* W = (which == 0 ? wsel0 : which == 1 ? wsel1 : wsel2) + (size_t)l * 1024 * 1024;
            conv_item(W + 32 * nb + nl, 1024, false, nullptr, 1024, (bf16*)(wl + (which == 0 ? WL_PA : which == 1 ? WL_PB : WL_OUT)), 32 * nb, 64 * kb, scr, lane);
            return;
        }
        r -= 3 * IT_SQ;
        if (r < IT_GU) {
            const int e = r / 512, rr = r % 512, kb = rr / 32, nb = rr % 32, np = 32 * nb + nl, f = 4 * (np >> 3) + (np & 3);
            const float* gsel0 = p.wg; const float* gsel1 = p.wu; asm volatile("" : "+s"(gsel0), "+s"(gsel1));
            const float* W = ((np & 4) ? gsel1 : gsel0) + ((size_t)l * NE + e) * 1024 * 512;
            conv_item(W + f, 512, false, nullptr, 1024, (bf16*)(wl + WL_GU) + (size_t)e * 1024 * 1024, 32 * nb, 64 * kb, scr, lane);
            return;
        }
        r -= IT_GU;
        { const int e = r / 256, rr = r % 256, kb = rr / 32, nb = rr % 32;
          const float* W = p.wd + ((size_t)l * NE + e) * 512 * 1024;
          conv_item(W + 32 * nb + nl, 1024, false, nullptr, 512, (bf16*)(wl + WL_D) + (size_t)e * 1024 * 512, 32 * nb, 64 * kb, scr, lane); }
    }
}
__device__ __forceinline__ void conv_layer_static(const P& p, int l, LAS unsigned char* lds, int gw, int ngw, int wave, int lane) {
    LAS float* scr = (LAS float*)(lds + wave * 16384);
    for (int r = gw; r < IT_LAYER; r += ngw) conv_layer_item(p, l, r, scr, lane);
}
#ifndef CONV_OVERLAP
#define CONV_OVERLAP 0
#endif
constexpr int CONV_CHUNK = 4, CW_CONV = 2048;
__device__ __forceinline__ void conv_layer_dynamic(const P& p, int l, LAS unsigned char* lds, int wave, int lane, int nchunks) {
    LAS float* scr = (LAS float*)(lds + wave * 16384);
    unsigned* cnt = (unsigned*)(p.ws + WS_CTL) + CW_CONV + 64 * l;
    for (int ch = 0; nchunks < 0 || ch < nchunks; ++ch) {
        unsigned r0 = 0; if (lane == 0) r0 = __hip_atomic_fetch_add(cnt, (unsigned)CONV_CHUNK, __ATOMIC_RELAXED, __HIP_MEMORY_SCOPE_AGENT);
        r0 = (unsigned)__builtin_amdgcn_readfirstlane((int)r0);
        if (r0 >= (unsigned)IT_LAYER) break;
        for (int q = 0; q < CONV_CHUNK; ++q) conv_layer_item(p, l, (int)r0 + q, scr, lane);
    }
}
__device__ __forceinline__ void prologue_mod(const P& p, LAS unsigned char* lds, int bid, int nb, int tid) {
    LAS float* cond = (LAS float*)lds; LAS float* part = (LAS float*)(lds + 32768);
    const int lane = tid & 63, w = tid >> 6;
    for (int i = tid; i < 8192; i += NTHR) cond[i] = siluf_(p.c[i]);
    __syncthreads();
    for (int u = bid; u < NL * NMOD / 64; u += nb) {
        const int l = u / (NMOD / 64), j = (u % (NMOD / 64)) * 64 + lane;
        float a0 = 0, a1 = 0, a2 = 0, a3 = 0, a4 = 0, a5 = 0, a6 = 0, a7 = 0;
        const float* wp = p.ada_w + ((size_t)l * 1024 + 128 * w) * NMOD + j; const LAS float* cw = cond + 128 * w;
#pragma unroll 16
        for (int k = 0; k < 128; ++k) {
            const float wv = wp[(size_t)k * NMOD];
            a0 += cw[k] * wv; a1 += cw[1024 + k] * wv; a2 += cw[2048 + k] * wv; a3 += cw[3072 + k] * wv;
            a4 += cw[4096 + k] * wv; a5 += cw[5120 + k] * wv; a6 += cw[6144 + k] * wv; a7 += cw[7168 + k] * wv;
        }
        LAS float* pw = part + w * 512 + lane;
        pw[0] = a0; pw[64] = a1; pw[128] = a2; pw[192] = a3; pw[256] = a4; pw[320] = a5; pw[384] = a6; pw[448] = a7;
        LDS_WAIT(); __syncthreads();
        {
            float sacc = p.ada_b[l * NMOD + j];
#pragma unroll
            for (int q = 0; q < 8; ++q) sacc += part[q * 512 + w * 64 + lane];
            ((float*)(p.ws + WS_MOD))[((size_t)l * 8 + w) * NMOD + j] = sacc;
        }
        __syncthreads();
    }
    __syncthreads();
}

constexpr int G1_TOT = 0, G1_QE = 2048, G1_KI = 2048 + 17408, G1_VT = 2048 + 2 * 17408;
struct G1In { float g[16]; unsigned short q[16], k[16]; u32x4 v[4]; };
__device__ __forceinline__ void gla1_zero(G1In& in) {
#pragma unroll
    for (int i = 0; i < 16; ++i) { in.g[i] = 0.f; in.q[i] = 0; in.k[i] = 0; }
#pragma unroll
    for (int i = 0; i < 4; ++i) in.v[i] = (u32x4){0u, 0u, 0u, 0u};
}
__device__ __forceinline__ void gla1_load(const P& p, int item, int tid, G1In& in) {
    const int bh = item >> 5, c = item & 31;
    const bf16* Qg = (const bf16*)(p.ws + WS_QA) + ((size_t)bh * SEQ + 64 * c) * 128;
    const bf16* Kg = (const bf16*)(p.ws + WS_KA) + ((size_t)bh * SEQ + 64 * c) * 128;
    const float* Gg = (const float*)(p.ws + WS_GA) + ((size_t)bh * SEQ + 64 * c) * 128;
    const bf16* Vg = (const bf16*)(p.ws + WS_VA) + ((size_t)bh * SEQ + 64 * c) * 256;
    const int d = tid & 127, t0 = 16 * (tid >> 7), s = tid & 63, vc0 = tid >> 6;
#pragma unroll
    for (int i = 0; i < 16; ++i) { in.g[i] = Gg[(t0 + i) * 128 + d]; in.q[i] = Qg[(t0 + i) * 128 + d]; in.k[i] = Kg[(t0 + i) * 128 + d]; }
#pragma unroll
    for (int ps = 0; ps < 4; ++ps) in.v[ps] = *(const u32x4*)(Vg + s * 256 + 8 * (vc0 + 8 * ps));
}
__device__ __forceinline__ void gla1_item(const P& p, LAS unsigned char* lds, int item, int tid, const G1In& in, bool st) {
    const int bh = item >> 5, c = item & 31, lane = tid & 63, w = __builtin_amdgcn_readfirstlane(tid >> 6);
    bf16* Qg = (bf16*)(p.ws + WS_QA) + ((size_t)bh * SEQ + 64 * c) * 128;
    bf16* Kg = (bf16*)(p.ws + WS_KA) + ((size_t)bh * SEQ + 64 * c) * 128;
    bf16* Vg = (bf16*)(p.ws + WS_VA) + ((size_t)bh * SEQ + 64 * c) * 256;
    LAS float* TOT = (LAS float*)(lds + G1_TOT); LAS bf16* QEl = (LAS bf16*)(lds + G1_QE); LAS bf16* KIl = (LAS bf16*)(lds + G1_KI); LAS bf16* VTl = (LAS bf16*)(lds + G1_VT);
    {
        const int d = tid & 127, qd = tid >> 7, t0 = 16 * qd;
        float bl[16], qv[16], kv[16]; unsigned used = 0u;
#pragma unroll
        for (int i = 0; i < 16; ++i) { bl[i] = in.g[i]; qv[i] = bf2f(in.q[i]); kv[i] = bf2f(in.k[i]); used |= (unsigned)in.q[i] | (unsigned)in.k[i]; }
        used |= in.v[0].x | in.v[1].x | in.v[2].x | in.v[3].x;
#pragma unroll
        for (int i = 1; i < 16; ++i) bl[i] += bl[i - 1];
        TOT[qd * 128 + d] = bl[15];
        asm volatile("" :: "v"(used));
        LDS_WAIT(); __syncthreads();
        const float t0v = TOT[d], t1v = TOT[128 + d], t2v = TOT[256 + d], t3v = TOT[384 + d];
        const float off = (qd > 0 ? t0v : 0.f) + (qd > 1 ? t1v : 0.f) + (qd > 2 ? t2v : 0.f), blast = (t0v + t1v) + (t2v + t3v);
        float ks[16];
#pragma unroll
        for (int i = 0; i < 16; ++i) { const float b = bl[i] + off;
            QEl[(t0 + i) * 136 + d] = f2bf(qv[i] * 0.08838834764831845f * __expf(b)); KIl[(t0 + i) * 136 + d] = f2bf(kv[i] * __expf(-b)); ks[i] = kv[i] * __expf(blast - b); }
        const int D = d >> 5, r = d & 31;
        u32x4 o0, o1; o0.x = cvtpk(ks[0], ks[1]); o0.y = cvtpk(ks[2], ks[3]); o0.z = cvtpk(ks[4], ks[5]); o0.w = cvtpk(ks[6], ks[7]);
        o1.x = cvtpk(ks[8], ks[9]); o1.y = cvtpk(ks[10], ks[11]); o1.z = cvtpk(ks[12], ks[13]); o1.w = cvtpk(ks[14], ks[15]);
        if (st) { *(u32x4*)(Kg + ((D * 4 + qd) * 64 + r) * 8) = o0; *(u32x4*)(Kg + ((D * 4 + qd) * 64 + 32 + r) * 8) = o1; }
        if (qd == 0 && st) ((float*)(p.ws + WS_DEC))[item * 128 + d] = __expf(blast);
    }
    {
        const int s = tid & 63, vc0 = tid >> 6;
#pragma unroll
        for (int ps = 0; ps < 4; ++ps) { const int vc = vc0 + 8 * ps; const u32x4 val = in.v[ps];
            LAS bf16* dst = VTl + (8 * vc) * 72 + s;
            dst[0 * 72] = (bf16)(val.x & 0xffff); dst[1 * 72] = (bf16)(val.x >> 16); dst[2 * 72] = (bf16)(val.y & 0xffff); dst[3 * 72] = (bf16)(val.y >> 16);
            dst[4 * 72] = (bf16)(val.z & 0xffff); dst[5 * 72] = (bf16)(val.z >> 16); dst[6 * 72] = (bf16)(val.w & 0xffff); dst[7 * 72] = (bf16)(val.w >> 16); }
    }
    LDS_WAIT(); __syncthreads();
    {
        const int ti = w & 1, vq = w >> 1, r = lane & 31, hh = lane >> 5;
        bf16x8 qf[8];
#pragma unroll
        for (int kk = 0; kk < 8; ++kk) qf[kk] = *(const LAS bf16x8*)(QEl + (32 * ti + r) * 136 + 16 * kk + 8 * hh);
        f32x16 z0, z1;
#pragma unroll
        for (int i = 0; i < 16; ++i) { z0[i] = 0.f; z1[i] = 0.f; }
#pragma unroll
        for (int si = 0; si < 2; ++si) {
            if (si <= ti) {
                f32x16 X;
#pragma unroll
                for (int i = 0; i < 16; ++i) X[i] = 0.f;
#pragma unroll
                for (int kk = 0; kk < 8; ++kk) { const bf16x8 kf = *(const LAS bf16x8*)(KIl + (32 * si + r) * 136 + 16 * kk + 8 * hh); X = MFMA32(kf, qf[kk], X); }
                if (si == ti) {
#pragma unroll
                    for (int i = 0; i < 16; ++i) X[i] = (crow(i, hh) <= r) ? X[i] : 0.f;
                }
                const bf16x8 x0 = pack_step<0>(X), x1 = pack_step<1>(X);
                const LAS bf16* v0p = VTl + (32 * (2 * vq) + r) * 72 + 32 * si + 4 * hh; const LAS bf16* v1p = v0p + 32 * 72;
                { const s16x4 lo = *(const LAS s16x4*)(v0p), hi = *(const LAS s16x4*)(v0p + 8); z0 = MFMA32(x0, __builtin_shufflevector(lo, hi, 0, 1, 2, 3, 4, 5, 6, 7), z0); }
                { const s16x4 lo = *(const LAS s16x4*)(v0p + 16), hi = *(const LAS s16x4*)(v0p + 24); z0 = MFMA32(x1, __builtin_shufflevector(lo, hi, 0, 1, 2, 3, 4, 5, 6, 7), z0); }
                { const s16x4 lo = *(const LAS s16x4*)(v1p), hi = *(const LAS s16x4*)(v1p + 8); z1 = MFMA32(x0, __builtin_shufflevector(lo, hi, 0, 1, 2, 3, 4, 5, 6, 7), z1); }
                { const s16x4 lo = *(const LAS s16x4*)(v1p + 16), hi = *(const LAS s16x4*)(v1p + 24); z1 = MFMA32(x1, __builtin_shufflevector(lo, hi, 0, 1, 2, 3, 4, 5, 6, 7), z1); }
            }
        }
        bf16* OI = (bf16*)(p.ws + WS_OI);
        { u32x4 a, b; a.x = cvtpk(z0[0], z0[1]); a.y = cvtpk(z0[2], z0[3]); a.z = cvtpk(z0[4], z0[5]); a.w = cvtpk(z0[6], z0[7]); b.x = cvtpk(z0[8], z0[9]); b.y = cvtpk(z0[10], z0[11]); b.z = cvtpk(z0[12], z0[13]); b.w = cvtpk(z0[14], z0[15]);
          bf16* dst = OI + ((((size_t)item * 8 + 2 * vq) * 2 + ti) * 64 + lane) * 16; if (st) { *(u32x4*)dst = a; *(u32x4*)(dst + 8) = b; } }
        { u32x4 a, b; a.x = cvtpk(z1[0], z1[1]); a.y = cvtpk(z1[2], z1[3]); a.z = cvtpk(z1[4], z1[5]); a.w = cvtpk(z1[6], z1[7]); b.x = cvtpk(z1[8], z1[9]); b.y = cvtpk(z1[10], z1[11]); b.z = cvtpk(z1[12], z1[13]); b.w = cvtpk(z1[14], z1[15]);
          bf16* dst = OI + ((((size_t)item * 8 + 2 * vq + 1) * 2 + ti) * 64 + lane) * 16; if (st) { *(u32x4*)dst = a; *(u32x4*)(dst + 8) = b; } }
    }
    {
        const int r = lane & 31, hh = lane >> 5;
#pragma unroll
        for (int ps = 0; ps < 2; ++ps) { const int f = w + 8 * ps, i = f >> 3, D = (f >> 1) & 3, s2 = f & 1;
            const LAS bf16* src = QEl + (32 * i + r) * 136 + 32 * D + 16 * s2 + 4 * hh;
            const u32x2 lo = *(const LAS u32x2*)src, hi = *(const LAS u32x2*)(src + 8);
            if (st) *(u32x4*)(Qg + (f * 64 + lane) * 8) = (u32x4){lo.x, lo.y, hi.x, hi.y}; }
#pragma unroll
        for (int ps = 0; ps < 4; ++ps) { const int ci = tid + 512 * ps, v = ci >> 3, sc = ci & 7;
            const u32x4 tv = *(const LAS u32x4*)(VTl + v * 72 + 8 * sc); if (st) *(u32x4*)(Vg + v * 64 + 8 * sc) = tv; }
    }
    LDS_WAIT(); __syncthreads();
}

__device__ __forceinline__ void swa_unit(const P& p, int l, LAS unsigned char* lds, int unit, int tid, bool st) {
    const int b = unit >> 7, kvh = (unit >> 6) & 1, qb = unit & 63, lane = tid & 63, g = __builtin_amdgcn_readfirstlane(tid >> 6), r = lane & 31, hh = lane >> 5;
    const int kb0 = 32 * qb - 128; const size_t tokb = (size_t)b * SEQ;
    LAS bf16* VTl = (LAS bf16*)lds;
    const bf16* VB = (const bf16*)(p.ws + WS_VB); const bf16* KB = (const bf16*)(p.ws + WS_KB); bf16* QB = (bf16*)(p.ws + WS_QB);
    for (int ci = tid; ci < 1280; ci += NTHR) { const int key = ci % 160, dc = ci / 160, kp = kb0 + key;
        u32x4 val = {0u, 0u, 0u, 0u}; if (kp >= 0) val = *(const u32x4*)(VB + (tokb + kp) * 128 + kvh * 64 + 8 * dc);
        LAS bf16* dst = VTl + (8 * dc) * 168 + key;
        dst[0 * 168] = (bf16)(val.x & 0xffff); dst[1 * 168] = (bf16)(val.x >> 16); dst[2 * 168] = (bf16)(val.y & 0xffff); dst[3 * 168] = (bf16)(val.y >> 16);
        dst[4 * 168] = (bf16)(val.z & 0xffff); dst[5 * 168] = (bf16)(val.z >> 16); dst[6 * 168] = (bf16)(val.w & 0xffff); dst[7 * 168] = (bf16)(val.w >> 16); }
    const int hq = kvh * 8 + g;
    bf16* Qrow = QB + (tokb + 32 * qb + r) * 1024 + hq * 64;
    bf16x8 qf[4];
#pragma unroll
    for (int kk = 0; kk < 4; ++kk) qf[kk] = *(const bf16x8*)(Qrow + 16 * kk + 8 * hh);
    f32x16 X[5];
#pragma unroll
    for (int kt = 0; kt < 5; ++kt) {
#pragma unroll
        for (int i = 0; i < 16; ++i) X[kt][i] = 0.f;
        const int kp = kb0 + 32 * kt + r, kpc = kp < 0 ? 0 : kp;
        const bf16* Krow = KB + (tokb + kpc) * 128 + kvh * 64 + 8 * hh;
#pragma unroll
        for (int kk = 0; kk < 4; ++kk) { const bf16x8 kf = *(const bf16x8*)(Krow + 16 * kk); X[kt] = MFMA32(kf, qf[kk], X[kt]); }
    }
    const int qp = 32 * qb + r; const float sink = p.sinks[l * 16 + hq];
    float mx = -1e30f;
#pragma unroll
    for (int kt = 0; kt < 5; ++kt)
#pragma unroll
        for (int i = 0; i < 16; ++i) { const int kp = kb0 + 32 * kt + crow(i, hh); const bool valid = (kp >= 0) && (kp <= qp) && (kp > qp - 128);
            X[kt][i] = valid ? X[kt][i] : -1e30f; mx = fmaxf(mx, X[kt][i]); }
    mx = fmaxf(mx, shx(mx, 32, lane)); mx = fmaxf(mx, sink);
    float sum = 0.f;
#pragma unroll
    for (int kt = 0; kt < 5; ++kt)
#pragma unroll
        for (int i = 0; i < 16; ++i) { const float pv = (X[kt][i] > -1e29f) ? __expf(X[kt][i] - mx) : 0.f; X[kt][i] = pv; sum += pv; }
    sum += shx(sum, 32, lane);
    const float inv = 1.0f / (sum + __expf(sink - mx));
    LDS_WAIT(); __syncthreads();
    f32x16 o0, o1;
#pragma unroll
    for (int i = 0; i < 16; ++i) { o0[i] = 0.f; o1[i] = 0.f; }
#pragma unroll
    for (int kt = 0; kt < 5; ++kt) {
        const bf16x8 x0 = pack_step<0>(X[kt]), x1 = pack_step<1>(X[kt]);
        const LAS bf16* v0p = VTl + r * 168 + 32 * kt + 4 * hh; const LAS bf16* v1p = v0p + 32 * 168;
        { const s16x4 lo = *(const LAS s16x4*)(v0p), hi = *(const LAS s16x4*)(v0p + 8); o0 = MFMA32(__builtin_shufflevector(lo, hi, 0, 1, 2, 3, 4, 5, 6, 7), x0, o0); }
        { const s16x4 lo = *(const LAS s16x4*)(v0p + 16), hi = *(const LAS s16x4*)(v0p + 24); o0 = MFMA32(__builtin_shufflevector(lo, hi, 0, 1, 2, 3, 4, 5, 6, 7), x1, o0); }
        { const s16x4 lo = *(const LAS s16x4*)(v1p), hi = *(const LAS s16x4*)(v1p + 8); o1 = MFMA32(__builtin_shufflevector(lo, hi, 0, 1, 2, 3, 4, 5, 6, 7), x0, o1); }
        { const s16x4 lo = *(const LAS s16x4*)(v1p + 16), hi = *(const LAS s16x4*)(v1p + 24); o1 = MFMA32(__builtin_shufflevector(lo, hi, 0, 1, 2, 3, 4, 5, 6, 7), x1, o1); }
    }
#pragma unroll
    for (int gq = 0; gq < 4; ++gq) {
        u32x2 a; a.x = cvtpk(o0[4 * gq] * inv, o0[4 * gq + 1] * inv); a.y = cvtpk(o0[4 * gq + 2] * inv, o0[4 * gq + 3] * inv);
        u32x2 c; c.x = cvtpk(o1[4 * gq] * inv, o1[4 * gq + 1] * inv); c.y = cvtpk(o1[4 * gq + 2] * inv, o1[4 * gq + 3] * inv);
        if (st) { *(u32x2*)(Qrow + 8 * gq + 4 * hh) = a; *(u32x2*)(Qrow + 32 + 8 * gq + 4 * hh) = c; }
    }
    __syncthreads();
}

constexpr int G2_QE = 0, G2_KS = 32768, G2_DEC = 65536, G2_GL = 66560, G2_OL = 67584;
#define GLDS16(gp, lp) __builtin_amdgcn_global_load_lds((const unsigned*)(gp), (LAS unsigned*)(lp), 16, 0, 0)
#define GLDS4(gp, lp) __builtin_amdgcn_global_load_lds((const unsigned*)(gp), (LAS unsigned*)(lp), 4, 0, 0)
__device__ __forceinline__ void gla2_bh(const P& p, int l, LAS unsigned char* lds, int bh, int tid, bool st) {
    { int t2 = tid; asm volatile("" : "+v"(t2));
      if (t2 < 64) { const f32x4 gv = *(const f32x4*)(p.glag + l * 256 + 4 * t2); *(LAS f32x4*)(lds + G2_GL + t2 * 16) = gv; } }
    const int lane = tid & 63, w = __builtin_amdgcn_readfirstlane(tid >> 6), r = lane & 31, hh = lane >> 5, b = bh >> 2, h = bh & 3;
    LAS float* Ol = (LAS float*)(lds + G2_OL);
    f32x16 S0, S1, S2, S3;
#pragma unroll
    for (int i = 0; i < 16; ++i) { S0[i] = 0.f; S1[i] = 0.f; S2[i] = 0.f; S3[i] = 0.f; }
    const char* Qbase = (const char*)((const bf16*)(p.ws + WS_QA) + (size_t)bh * SEQ * 128);
    const char* Kbase = (const char*)((const bf16*)(p.ws + WS_KA) + (size_t)bh * SEQ * 128);
    const bf16* Vbase = (const bf16*)(p.ws + WS_VA) + (size_t)bh * SEQ * 256 + (32 * w + r) * 64 + 8 * hh;
    const bf16* OIbase = (const bf16*)(p.ws + WS_OI) + (((size_t)bh * 32 * 8 + w) * 2 * 64 + lane) * 16;
    const float* DECbase = (const float*)(p.ws + WS_DEC) + (size_t)bh * 32 * 128;
    const int t = tid >> 3, seg = tid & 7;
    bf16* Rbase = (bf16*)(p.ws + WS_RA) + ((size_t)b * SEQ + t) * 1024 + h * 256 + 32 * seg;
    const LAS float* gg = (const LAS float*)(lds + G2_GL) + 32 * seg;
#define G2_ISSUE(c_, B_) do { const int c__ = (c_); constexpr int buf__ = (B_); \
        if (w < 4) { _Pragma("unroll") for (int q = 0; q < 4; ++q) GLDS16(Qbase + (size_t)c__ * 16384 + (4 * w + q) * 1024 + lane * 16, lds + G2_QE + buf__ * 16384 + (4 * w + q) * 1024); } \
        else { _Pragma("unroll") for (int q = 0; q < 4; ++q) GLDS16(Kbase + (size_t)c__ * 16384 + (4 * (w - 4) + q) * 1024 + lane * 16, lds + G2_KS + buf__ * 16384 + (4 * (w - 4) + q) * 1024); } \
        if (w < 2) GLDS4(DECbase + c__ * 128 + 64 * w + lane, lds + G2_DEC + buf__ * 512 + 256 * w); } while (0)
#define G2_LOADV(c_, V_) do { const int c__ = (c_); \
        _Pragma("unroll") for (int ks = 0; ks < 4; ++ks) V_[ks] = *(const bf16x8*)(Vbase + (size_t)c__ * 64 * 256 + 16 * ks); } while (0)
#define G2_LOADOR(c_, O_) do { const int c__ = (c_); \
        O_[0] = *(const u32x4*)(OIbase + (size_t)c__ * 8 * 2 * 64 * 16); O_[1] = *(const u32x4*)(OIbase + (size_t)c__ * 8 * 2 * 64 * 16 + 8); \
        O_[2] = *(const u32x4*)(OIbase + (size_t)c__ * 8 * 2 * 64 * 16 + 64 * 16); O_[3] = *(const u32x4*)(OIbase + (size_t)c__ * 8 * 2 * 64 * 16 + 64 * 16 + 8); } while (0)
#define G2_LOADRA(c_, R_) do { const int c__ = (c_); _Pragma("unroll") for (int q = 0; q < 4; ++q) R_[q] = *(const u32x4*)(Rbase + (size_t)c__ * 64 * 1024 + 8 * q); } while (0)
    bf16x8 vc[4], vn[4]; u32x4 oc[4], rc[4], on[4];
    G2_ISSUE(0, 0); G2_LOADV(0, vc); G2_LOADOR(0, oc);
#pragma unroll
    for (int q = 0; q < 4; ++q) { vn[q] = vc[q]; on[q] = oc[q]; }
#define G2_STEP(c_, BUF_) do { const int c = (c_); \
        __builtin_amdgcn_s_waitcnt(0x0F70)  ; LDS_WAIT(); __builtin_amdgcn_s_barrier(); asm volatile("" ::: "memory"); \
        G2_LOADRA(c, rc); \
        if (c + 1 < 32) { G2_ISSUE(c + 1, 1 - (BUF_)); G2_LOADV(c + 1, vn); G2_LOADOR(c + 1, on); } \
        const LAS unsigned char* QEb = lds + G2_QE + (BUF_) * 16384 + lane * 16; const LAS unsigned char* KSb = lds + G2_KS + (BUF_) * 16384 + lane * 16; \
        const LAS float* DECb = (const LAS float*)(lds + G2_DEC + (BUF_) * 512); \
        f32x16 o0; bf16x8 fa[8]; \
        _Pragma("unroll") for (int f = 0; f < 8; ++f) fa[f] = *(const LAS bf16x8*)(QEb + f * 1024);            \
        G2_UNPK(o0, oc[0], oc[1]); \
        o0 = MFMA32(fa[0], pack_step<0>(S0), o0); o0 = MFMA32(fa[1], pack_step<1>(S0), o0); o0 = MFMA32(fa[2], pack_step<0>(S1), o0); o0 = MFMA32(fa[3], pack_step<1>(S1), o0); \
        o0 = MFMA32(fa[4], pack_step<0>(S2), o0); o0 = MFMA32(fa[5], pack_step<1>(S2), o0); o0 = MFMA32(fa[6], pack_step<0>(S3), o0); o0 = MFMA32(fa[7], pack_step<1>(S3), o0); \
        _Pragma("unroll") for (int f = 0; f < 8; ++f) fa[f] = *(const LAS bf16x8*)(QEb + (8 + f) * 1024); \
        _Pragma("unroll") for (int i = 0; i < 16; ++i) Ol[crow(i, hh) * 260 + 32 * w + r] = o0[i]; \
        G2_UNPK(o0, oc[2], oc[3]); \
        o0 = MFMA32(fa[0], pack_step<0>(S0), o0); o0 = MFMA32(fa[1], pack_step<1>(S0), o0); o0 = MFMA32(fa[2], pack_step<0>(S1), o0); o0 = MFMA32(fa[3], pack_step<1>(S1), o0); \
        o0 = MFMA32(fa[4], pack_step<0>(S2), o0); o0 = MFMA32(fa[5], pack_step<1>(S2), o0); o0 = MFMA32(fa[6], pack_step<0>(S3), o0); o0 = MFMA32(fa[7], pack_step<1>(S3), o0); \
        _Pragma("unroll") for (int f = 0; f < 8; ++f) fa[f] = *(const LAS bf16x8*)(KSb + f * 1024); \
        _Pragma("unroll") for (int i = 0; i < 16; ++i) Ol[(32 + crow(i, hh)) * 260 + 32 * w + r] = o0[i]; \
        GLA2_DECAY(0, S0); GLA2_DECAY(1, S1); \
        _Pragma("unroll") for (int ks = 0; ks < 4; ++ks) { S0 = MFMA32(fa[ks], vc[ks], S0); S1 = MFMA32(fa[4 + ks], vc[ks], S1); } \
        _Pragma("unroll") for (int f = 0; f < 8; ++f) fa[f] = *(const LAS bf16x8*)(KSb + (8 + f) * 1024); \
        GLA2_DECAY(2, S2); GLA2_DECAY(3, S3); \
        _Pragma("unroll") for (int ks = 0; ks < 4; ++ks) { S2 = MFMA32(fa[ks], vc[ks], S2); S3 = MFMA32(fa[4 + ks], vc[ks], S3); } \
        LDS_WAIT(); __builtin_amdgcn_s_barrier(); asm volatile("" ::: "memory"); \
        {     \
            f32x4 ov[8]; float ss = 0.f; \
            _Pragma("unroll") for (int q = 0; q < 8; ++q) { ov[q] = *(const LAS f32x4*)(Ol + t * 260 + 32 * seg + 4 * q); ss += (ov[q][0] * ov[q][0] + ov[q][1] * ov[q][1]) + (ov[q][2] * ov[q][2] + ov[q][3] * ov[q][3]); } \
            ss += shx(ss, 1, lane); ss += shx(ss, 2, lane); ss += shx(ss, 4, lane); \
            const float rstd = 1.0f / sqrtf(ss * (1.0f / 256.0f) + EPS); \
            bf16* R = Rbase + (size_t)c * 64 * 1024; \
            _Pragma("unroll") for (int q = 0; q < 4; ++q) { const u32x4 rv = rc[q]; const f32x4 g0 = *(const LAS f32x4*)(gg + 8 * q), g1 = *(const LAS f32x4*)(gg + 8 * q + 4); \
                const f32x4 a = ov[2 * q] * rstd * g0 * bflo4((u32x2){rv.x, rv.y}), bq = ov[2 * q + 1] * rstd * g1 * bflo4((u32x2){rv.z, rv.w}); \
                if (st) *(u32x4*)(R + 8 * q) = pack8(a, bq); } \
        } \
        _Pragma("unroll") for (int q = 0; q < 4; ++q) { vc[q] = vn[q]; oc[q] = on[q]; } } while (0)
#define G2_UNPK(O_, A_, B_) do { O_[0] = lo16(A_.x); O_[1] = hi16(A_.x); O_[2] = lo16(A_.y); O_[3] = hi16(A_.y); O_[4] = lo16(A_.z); O_[5] = hi16(A_.z); O_[6] = lo16(A_.w); O_[7] = hi16(A_.w); \
            O_[8] = lo16(B_.x); O_[9] = hi16(B_.x); O_[10] = lo16(B_.y); O_[11] = hi16(B_.y); O_[12] = lo16(B_.z); O_[13] = hi16(B_.z); O_[14] = lo16(B_.w); O_[15] = hi16(B_.w); } while (0)
#define GLA2_DECAY(D, SD) do { _Pragma("unroll") for (int gq = 0; gq < 4; ++gq) { const f32x4 dv = *(const LAS f32x4*)(DECb + 32 * (D) + 8 * gq + 4 * hh); \
                SD[4 * gq] *= dv[0]; SD[4 * gq + 1] *= dv[1]; SD[4 * gq + 2] *= dv[2]; SD[4 * gq + 3] *= dv[3]; } } while (0)
    for (int c2 = 0; c2 < 32; c2 += 2) { G2_STEP(c2, 0); G2_STEP(c2 + 1, 1); }
#undef G2_STEP
#undef G2_UNPK
#undef GLA2_DECAY
    VM_WAIT(); LDS_WAIT(); __builtin_amdgcn_s_barrier(); asm volatile("" ::: "memory");
#undef G2_ISSUE
#undef G2_LOADV
#undef G2_LOADOR
#undef G2_LOADRA
}

__device__ __forceinline__ void t2_group(const P& p, int l, LAS unsigned char* lds, int grp, int tid, bool st) {
    const int lane = tid & 63, w = __builtin_amdgcn_readfirstlane(tid >> 6);
    LAS int* REl = (LAS int*)(lds + LX_RE); LAS int* RKl = (LAS int*)(lds + LX_RANK); LAS int* BSl = (LAS int*)(lds + LX_BASE);
    const float* modl = (const float*)(p.ws + WS_MOD) + (size_t)l * 8 * NMOD;
    LAS float* bpart = (LAS float*)lds; LAS float* rbias = (LAS float*)(lds + 1024);
    {   const int bb = (grp * 64) >> 11, e = lane & 15, ks = lane >> 4; const float* sh = modl + 3072 + bb * NMOD; float a = 0.f;
        for (int i = 0; i < 32; ++i) { const int k = 128 * w + ks + 4 * i; a += sh[k] * p.rw[k * 16 + e]; }
        a += shx(a, 16, lane); a += shx(a, 32, lane);
        if (lane < 16) bpart[w * 16 + lane] = a; }
    LDS_WAIT(); __syncthreads();
    if (tid < 16) { float a = 0.f;
#pragma unroll
        for (int q = 0; q < 8; ++q) a += bpart[q * 16 + tid];
        rbias[tid] = a; }
    LDS_WAIT(); __syncthreads();
    f32x4 vc[4], vn[4]; const float* Xp = (const float*)(p.ws + WS_X); const float* PLG = (const float*)(p.ws + WS_PLG);
    float pc = 0.f, pn_ = 0.f;
#define T2_PART(m_) ((lane < 16) ? ((PLG[(size_t)(m_) * 16 + lane] + PLG[((size_t)NTOK + (m_)) * 16 + lane]) + (PLG[((size_t)2 * NTOK + (m_)) * 16 + lane] + PLG[((size_t)3 * NTOK + (m_)) * 16 + lane])) : 0.f)
    row_load(Xp, grp * 64 + w * 8, lane, vc); pc = T2_PART(grp * 64 + w * 8);
#pragma unroll
    for (int j = 0; j < 4; ++j) vn[j] = vc[j];
    pn_ = pc;
#pragma unroll 1
    for (int i = 0; i < 8; ++i) { const int tl = w * 8 + i;
        if (i + 1 < 8) { row_load(Xp, grp * 64 + tl + 1, lane, vn); pn_ = T2_PART(grp * 64 + tl + 1); }
        token_row(p, l, grp * 64 + tl, lane, st ? 8 : (8 | 64), vc, p.n2g + l * DM, modl + 4096, modl + 3072, nullptr, 0, REl + 2 * tl, pc, rbias);
#pragma unroll
        for (int j = 0; j < 4; ++j) vc[j] = vn[j];
        pc = pn_; }
#undef T2_PART
    LDS_WAIT(); __syncthreads();
    unsigned* CNT = (unsigned*)(p.ws + WS_CTL) + CW_CNT + 64 * l;
    LAS int* CWl = (LAS int*)(lds + LX_RANK);
    int myrank = 0, mye = 0;
    if (tid < 128) {
        mye = REl[tid];
        const unsigned long long lt = (1ull << lane) - 1ull; int mycnt = 0;
#pragma unroll
        for (int e = 0; e < 16; ++e) { const unsigned long long m = __builtin_amdgcn_ballot_w64(mye == e);
            if (mye == e) myrank = __builtin_popcountll(m & lt);
            if (lane == e) mycnt = __builtin_popcountll(m); }
        if (lane < 16) CWl[w * 16 + lane] = mycnt;
    }
    LDS_WAIT(); __syncthreads();
    if (tid < 16) { const int cnt = CWl[tid] + CWl[16 + tid];
        BSl[tid] = st ? (int)__hip_atomic_fetch_add(CNT + tid, (unsigned)cnt, __ATOMIC_RELAXED, __HIP_MEMORY_SCOPE_AGENT) : 0; }
    LDS_WAIT(); __syncthreads();
    if (tid < 128 && st) { const int slot = BSl[mye] + myrank + (w == 1 ? CWl[mye] : 0), tok = grp * 64 + (tid >> 1);
        ((unsigned*)(p.ws + WS_RS))[2 * tok + (tid & 1)] = (unsigned)slot; ((int*)(p.ws + WS_ROWIDX))[mye * NTOK + slot] = tok; }
    __syncthreads();
}
__device__ __forceinline__ void moe_setup(const P& p, int l, LAS unsigned char* lds, int tid, int G, int c, bool rows) {
    LAS int* TS = (LAS int*)(lds + LX_TS); LAS int* CN = (LAS int*)(lds + LX_CNT); LAS unsigned* RT = (LAS unsigned*)(lds + LX_ROWS);
    const unsigned* CNT = (const unsigned*)(p.ws + WS_CTL) + CW_CNT + 64 * l;
    if (tid < 64) { const int cn = tid < 16 ? (int)CNT[tid] : 0; const int tl = (cn + 255) >> 8; int s = tl;
#pragma unroll
        for (int o = 1; o < 16; o <<= 1) { const int t = shl_from(s, tid - o); if ((tid & 15) >= o) s += t; }
        if (tid < 16) { TS[tid] = s - tl; CN[tid] = cn; if (tid == 15) TS[16] = s; } }
    LDS_WAIT(); __syncthreads();
    if (rows) {
        for (int i = 0; i < 4; ++i) { const int L = i * G + c; if (L >= 4 * TS[16]) break;
            const int rt = L >> 2; int e = 0;
#pragma unroll
            for (int q = 1; q < 16; ++q) e += (rt >= TS[q]) ? 1 : 0;
            if (tid < 256) { const int slot = 256 * (rt - TS[e]) + tid; const int tok = slot < CN[e] ? ((const int*)(p.ws + WS_ROWIDX))[e * NTOK + slot] : 0; RT[i * 256 + tid] = (unsigned)tok * 2048u; } }
        LDS_WAIT(); __syncthreads();
    }
}
constexpr int N_PHASES = 38;
#ifndef MK_MASK
#define MK_MASK 0x7ff
#endif
#define PH_ON(b) ((MK_MASK >> (b)) & 1)
#ifndef REP_PRO
#define REP_PRO 0
#endif
#ifndef REP_G1
#define REP_G1 0
#endif
#ifndef REP_G2
#define REP_G2 0
#endif
#ifndef REP_G4
#define REP_G4 0
#endif
#ifndef REP_G5
#define REP_G5 0
#endif
#ifndef DRY_GLA1
#define DRY_GLA1 0
#endif
#ifndef DRY_SWA
#define DRY_SWA 0
#endif
#ifndef DRY_GLA2
#define DRY_GLA2 0
#endif
#ifndef PROBE_G1_NOST
#define PROBE_G1_NOST 0
#endif
#ifndef PROBE_G1_NOEPI
#define PROBE_G1_NOEPI 0
#endif
#ifndef PROBE_G1_HOT
#define PROBE_G1_HOT 0
#endif
#ifndef A2_DRY_PART
#define A2_DRY_PART 0
#endif
struct MKArgs { P p; int ph_lo, ph_hi, dry, pad; };
typedef const __attribute__((address_space(4))) MKArgs* KArgP;
#if defined(__HIP_DEVICE_COMPILE__)
#define PHASE_LOADP() KArgP kp_ = (KArgP)__builtin_amdgcn_kernarg_segment_ptr(); asm volatile("" : "+s"(kp_)); P p; p.x = kp_->p.x; p.c = kp_->p.c; p.pos = kp_->p.pos; p.ada_w = kp_->p.ada_w; p.ada_b = kp_->p.ada_b; p.n1g = kp_->p.n1g; p.n2g = kp_->p.n2g; p.fg = kp_->p.fg; p.w_in = kp_->p.w_in; p.aw = kp_->p.aw; p.ab = kp_->p.ab; p.glag = kp_->p.glag; p.sinks = kp_->p.sinks; p.w_pa = kp_->p.w_pa; p.w_pb = kp_->p.w_pb; p.w_out = kp_->p.w_out; p.rw = kp_->p.rw; p.rb = kp_->p.rb; p.wg = kp_->p.wg; p.wu = kp_->p.wu; p.wd = kp_->p.wd; p.out = kp_->p.out; p.ws = kp_->p.ws;
#else
#define PHASE_LOADP() const P p = a.p;
#endif
#define PHASE_ENV() PHASE_LOADP() \
    int tid; asm volatile("v_mbcnt_lo_u32_b32 %0, -1, 0\n\tv_mbcnt_hi_u32_b32 %0, -1, %0" : "=v"(tid)); tid += wave_s * 64; int bid = blockIdx.x; asm volatile("" : "+s"(bid)); int G = gridDim.x; asm volatile("" : "+s"(G)); \
    const int lane = tid & 63, wave = __builtin_amdgcn_readfirstlane(tid >> 6); (void)lane; (void)wave; \
    unsigned* ctl = (unsigned*)(p.ws + WS_CTL); const float* MOD = (const float*)(p.ws + WS_MOD); float* X = (float*)(p.ws + WS_X); (void)ctl; (void)MOD; (void)X;
__global__ void __launch_bounds__(NTHR, 2) mk(MKArgs a) {
    extern __shared__ __attribute__((aligned(16))) unsigned char lds_raw[];
    LAS unsigned char* lds = (LAS unsigned char*)lds_raw;
    const int lo = a.ph_lo, hi = a.ph_hi; const bool st_all = (a.dry == 0);
    const int wave_s = __builtin_amdgcn_readfirstlane(threadIdx.x >> 6);
    for (int u = threadIdx.x; u < (LDS_BYTES - LX_OFF) / 4; u += NTHR) ((LAS unsigned*)(lds + LX_OFF))[u] = 0u;
    __syncthreads();
    XcdBarrier bar; bar.bar = (unsigned*)(a.p.ws + WS_CTL) + CW_BAR; bar.x = 0; bar.st = (volatile LAS unsigned*)(lds + LX_BAR);
    if (hi - lo > 1) bar = xcd_barrier_post((unsigned*)(a.p.ws + WS_CTL) + CW_BAR, (volatile LAS unsigned*)(lds + LX_BAR));
#define IN(k) (lo <= (k) && (k) < hi)
#define SEAM(k) do { if (IN(k) && IN((k) + 1)) xcd_barrier(bar); } while (0)

    if (IN(0) && PH_ON(0)) {
        PHASE_ENV();
        for (int rep = 0; rep <= REP_PRO; ++rep) {
        prologue_mod(p, lds, bid, G, tid);
        for (int idx = bid * NTHR + tid; idx < NTOK * 32; idx += G * NTHR) rope_entry(p.pos, (float2*)(p.ws + WS_ROPE), idx);
        conv_layer_static(p, 0, lds, bid * NWAVES + wave, G * NWAVES, wave, lane);
        if (!CONV_OVERLAP) { for (int ll = 1; ll < NL; ++ll) conv_layer_static(p, ll, lds, bid * NWAVES + wave, G * NWAVES, wave, lane); }
        __syncthreads(); }
    }
    SEAM(0);
    for (int l = 0; l < NL; ++l) {
        const int base = 1 + 9 * l;
        if (IN(base + 0) && PH_ON(1)) {
            PHASE_ENV();
            const float* modl = MOD + (size_t)l * 8 * NMOD;
            const int mode = (l > 0 ? (1 | 16) : 0) | 2 | (st_all ? 0 : 64);
            const int startv = (l > 0) ? expert_start_lane(ctl + CW_CNT + 64 * (l - 1), lane) : 0;
            const float* xin = (l == 0) ? p.x : (const float*)X;
            const float* g2prev = MOD + (size_t)(l > 0 ? l - 1 : 0) * 8 * NMOD + 5120;
            if (l > 0 && CONV_OVERLAP) conv_layer_dynamic(p, l, lds, wave, lane, -1);
            { f32x4 vc[4], vn[4]; const int m0 = bid * NWAVES + wave, stp = G * NWAVES;
#pragma unroll
              for (int j = 0; j < 4; ++j) vc[j] = (f32x4){0.f, 0.f, 0.f, 0.f};
              if (m0 < NTOK) row_load(xin, m0, lane, vc);
#pragma unroll
              for (int j = 0; j < 4; ++j) vn[j] = vc[j];
              for (int m = m0; m < NTOK; m += stp) { if (m + stp < NTOK) row_load(xin, m + stp, lane, vn);
                  token_row(p, l, m, lane, mode, vc, p.n1g + l * DM, modl + 1024, modl + 0, g2prev, startv, (LAS int*)nullptr);
#pragma unroll
                  for (int j = 0; j < 4; ++j) vc[j] = vn[j]; } }
        }
        SEAM(base + 0);
        if (IN(base + 1) && PH_ON(2)) {
            PHASE_ENV();
            unsigned char* wl = p.ws + WS_W + (size_t)l * WL_STRIDE;
            pg8::SchedStatic S{64, NIN / 256, G, bid, (const char*)(p.ws + WS_H), (const char*)(wl + WL_IN), (size_t)256 * 1024 * 2, (size_t)256 * 1024 * 2};
            EpiInProj E{p.ws, p.ab + l * 512, (PROBE_G1_NOEPI && !st_all), (PROBE_G1_NOST && !st_all)};
            if (PROBE_G1_HOT && !st_all) { S.ta = 0; S.tb = 0; }
            for (int rep = 0; rep <= REP_G1; ++rep) pg8::gemm_phase<EpiInProj, pg8::SchedStatic, false>(lds, tid, 1024, S, E);

        }
        if (IN(base + 1) && PH_ON(2) && l + 1 < NL && CONV_OVERLAP) {
            PHASE_ENV();
            const int nun = 64 * (NIN / 256), mine = (nun - bid + G - 1) / G, mx = (nun + G - 1) / G;
            if (mine < mx) conv_layer_dynamic(p, l + 1, lds, wave, lane, 2 * (mx - mine));
        }
        SEAM(base + 1);
        if (IN(base + 2) && PH_ON(3)) {
            PHASE_ENV();
            const bool never = (p.ws == nullptr);
            (void)never;
            G1In cur, nxt; int it = bid;
            gla1_zero(cur);
            if (it < 1024) gla1_load(p, it, tid, cur);
            nxt = cur;
            for (; it < 1024; it += G) { if (it + G < 1024) gla1_load(p, it + G, tid, nxt); gla1_item(p, lds, it, tid, cur, st_all); cur = nxt; }
        }
        SEAM(base + 2);
        if (IN(base + 3) && PH_ON(4)) {
            {   PHASE_ENV();
                const int NG2 = (G >= 64) ? 32 : (G > 1 ? G / 2 : 1);
                if (bid < NG2 && (st_all || A2_DRY_PART != 2)) { for (int bh = bid; bh < 32; bh += NG2) gla2_bh(p, l, lds, bh, tid, st_all); } }
            {   PHASE_ENV();
                const int NG2 = (G >= 64) ? 32 : (G > 1 ? G / 2 : 1);
                if ((G == 1 || bid >= NG2) && (st_all || A2_DRY_PART != 1)) { const int nsw = (G == 1) ? 1 : G - NG2, first = (G == 1) ? 0 : bid - NG2; for (int u = first; u < 1024; u += nsw) swa_unit(p, l, lds, u, tid, st_all); } }
        }
        SEAM(base + 3);
        if (IN(base + 4) && PH_ON(5)) {
            PHASE_ENV();
            unsigned char* wl = p.ws + WS_W + (size_t)l * WL_STRIDE;
            pg8::SchedPair S{64, 4, G, bid, (const char*)(p.ws + WS_RA), (const char*)(wl + WL_PA), (const char*)(p.ws + WS_QB), (const char*)(wl + WL_PB), (size_t)256 * 1024 * 2, (size_t)256 * 1024 * 2};
            EpiMerge E{p.ws};
            for (int rep = 0; rep <= REP_G2; ++rep) pg8::gemm_phase<EpiMerge, pg8::SchedPair, false>(lds, tid, 1024, S, E);
        }
        SEAM(base + 4);
        if (IN(base + 5) && PH_ON(6)) {
            PHASE_ENV();
            unsigned char* wl = p.ws + WS_W + (size_t)l * WL_STRIDE;
            pg8::SchedStatic S{64, 4, G, bid, (const char*)(p.ws + WS_H), (const char*)(wl + WL_OUT), (size_t)256 * 1024 * 2, (size_t)256 * 1024 * 2};
            EpiResid E{X, MOD + (size_t)l * 8 * NMOD + 2048, p.n2g + l * DM, MOD + (size_t)l * 8 * NMOD + 4096, p.rw, (float*)(p.ws + WS_PLG), st_all};
            pg8::gemm_phase<EpiResid, pg8::SchedStatic, false>(lds, tid, 1024, S, E);
        }
        SEAM(base + 5);
        if (IN(base + 6) && PH_ON(7)) {
            PHASE_ENV();
            for (int grp = bid; grp < NTOK / 64; grp += G) t2_group(p, l, lds, grp, tid, st_all);
        }
        SEAM(base + 6);
        if (IN(base + 7) && PH_ON(8)) {
            PHASE_ENV();
            unsigned char* wl = p.ws + WS_W + (size_t)l * WL_STRIDE;
            moe_setup(p, l, lds, tid, G, bid, true);
            pg8::SchedMoe S{G, bid, (const LAS int*)(lds + LX_TS), (const LAS unsigned*)(lds + LX_ROWS), (const char*)(p.ws + WS_H), (const char*)(wl + WL_GU), (size_t)0, (size_t)1024 * 1024 * 2, (size_t)256 * 1024 * 2};
            EpiMoeUp E{(bf16*)(p.ws + WS_HID)};
            for (int rep = 0; rep <= REP_G4; ++rep) pg8::gemm_phase<EpiMoeUp, pg8::SchedMoe, true>(lds, tid, 1024, S, E);

        }
        if (IN(base + 7) && PH_ON(8) && l + 1 < NL && CONV_OVERLAP) {
            PHASE_ENV();
            const int nun = 4 * ((const LAS int*)(lds + LX_TS))[16], mine = nun > bid ? (nun - bid + G - 1) / G : 0, mx = (nun + G - 1) / G;
            if (mine < mx) conv_layer_dynamic(p, l + 1, lds, wave, lane, 2 * (mx - mine));
        }
        SEAM(base + 7);
        if (IN(base + 8) && PH_ON(9)) {
            PHASE_ENV();
            unsigned char* wl = p.ws + WS_W + (size_t)l * WL_STRIDE;
            moe_setup(p, l, lds, tid, G, bid, false);
            pg8::SchedMoe S{G, bid, (const LAS int*)(lds + LX_TS), (const LAS unsigned*)(lds + LX_ROWS), (const char*)(p.ws + WS_HID), (const char*)(wl + WL_D), (size_t)256 * 512 * 2, (size_t)1024 * 512 * 2, (size_t)256 * 512 * 2};
            EpiMoeDown E{(bf16*)(p.ws + WS_Y)};
            for (int rep = 0; rep <= REP_G5; ++rep) pg8::gemm_phase<EpiMoeDown, pg8::SchedMoe, false>(lds, tid, 512, S, E);

        }
        if (IN(base + 8) && PH_ON(9) && l + 1 < NL && CONV_OVERLAP) {
            PHASE_ENV();
            const int nun = 4 * ((const LAS int*)(lds + LX_TS))[16], mine = nun > bid ? (nun - bid + G - 1) / G : 0, mx = (nun + G - 1) / G;
            if (mine < mx) conv_layer_dynamic(p, l + 1, lds, wave, lane, (mx - mine));
        }
        SEAM(base + 8);
    }
    if (IN(N_PHASES - 1) && PH_ON(10)) {
        PHASE_ENV();
        const int startv = expert_start_lane(ctl + CW_CNT + 64 * (NL - 1), lane);
        const float* g2prev = MOD + (size_t)(NL - 1) * 8 * NMOD + 5120;
        { f32x4 vc[4], vn[4]; const int m0 = bid * NWAVES + wave, stp = G * NWAVES;
#pragma unroll
          for (int j = 0; j < 4; ++j) vc[j] = (f32x4){0.f, 0.f, 0.f, 0.f};
          if (m0 < NTOK) row_load((const float*)X, m0, lane, vc);
#pragma unroll
          for (int j = 0; j < 4; ++j) vn[j] = vc[j];
          for (int m = m0; m < NTOK; m += stp) { if (m + stp < NTOK) row_load((const float*)X, m + stp, lane, vn);
              token_row(p, NL, m, lane, 1 | 16 | 4 | (st_all ? 0 : 64), vc, p.fg, MOD, MOD, g2prev, startv, (LAS int*)nullptr);
#pragma unroll
              for (int j = 0; j < 4; ++j) vc[j] = vn[j]; } }
    }
#undef IN
#undef SEAM
}

#ifndef MK_PER_PHASE
#define MK_PER_PHASE 0
#endif
#ifndef PROBE_DUP_KIND
#define PROBE_DUP_KIND -1
#endif
#ifndef PROBE_DUP_N
#define PROBE_DUP_N 3
#endif
extern "C" void kernel_launch(void* const* d_in, const int* in_sizes, int n_in, void* d_out, int out_size, void* d_ws, size_t ws_size, hipStream_t stream) {
    if (n_in != 21 || out_size != NTOK * DM || ws_size < WS_END) { fprintf(stderr, "kernel_launch: unexpected shapes (n_in %d out %d ws %zu)\n", n_in, out_size, ws_size); return; }
    static int grid = 0;
    if (grid == 0) {
        int dev = 0, cus = 0, per_cu = 0;
        if (hipGetDevice(&dev) != hipSuccess || hipDeviceGetAttribute(&cus, hipDeviceAttributeMultiprocessorCount, dev) != hipSuccess) { grid = -1; return; }
        if (hipFuncSetAttribute((const void*)mk, hipFuncAttributeMaxDynamicSharedMemorySize, LDS_BYTES) != hipSuccess) { fprintf(stderr, "kernel_launch: hipFuncSetAttribute failed\n"); grid = -1; return; }
        if (hipOccupancyMaxActiveBlocksPerMultiprocessor(&per_cu, (const void*)mk, NTHR, LDS_BYTES) != hipSuccess || per_cu < 1) fprintf(stderr, "kernel_launch: occupancy query says %d\n", per_cu);
        (void)hipGetLastError();
        if (cus < 256) { fprintf(stderr, "kernel_launch: built for a 256-CU device (one 256x256 out-projection unit per workgroup); found %d CUs\n", cus); grid = -1; return; }
        grid = 256;
    }
    if (grid < 0) return;
    MKArgs a{};
    P& p = a.p;
    p.x = (const float*)d_in[0]; p.c = (const float*)d_in[1]; p.pos = (const int*)d_in[2]; p.ada_w = (const float*)d_in[3]; p.ada_b = (const float*)d_in[4];
    p.n1g = (const float*)d_in[5]; p.n2g = (const float*)d_in[6]; p.fg = (const float*)d_in[7]; p.w_in = (const float*)d_in[8]; p.aw = (const float*)d_in[9]; p.ab = (const float*)d_in[10];
    p.glag = (const float*)d_in[11]; p.sinks = (const float*)d_in[12]; p.w_pa = (const float*)d_in[13]; p.w_pb = (const float*)d_in[14]; p.w_out = (const float*)d_in[15];
    p.rw = (const float*)d_in[16]; p.rb = (const float*)d_in[17]; p.wg = (const float*)d_in[18]; p.wu = (const float*)d_in[19]; p.wd = (const float*)d_in[20];
    p.out = (float*)d_out; p.ws = (unsigned char*)d_ws;
    (void)hipMemsetAsync(p.ws + WS_CTL, 0, CTL_BYTES, stream);
#if MK_PER_PHASE
    for (int ph = 0; ph < N_PHASES; ++ph) {
        const int kind = (ph == 0) ? 9 : (ph == N_PHASES - 1) ? 10 : (ph - 1) % 9;
        a.ph_lo = ph; a.ph_hi = ph + 1;
        if (kind == PROBE_DUP_KIND) { a.dry = 1; for (int r = 0; r < PROBE_DUP_N; ++r) hipLaunchKernelGGL(mk, dim3(grid), dim3(NTHR), LDS_BYTES, stream, a); }
        a.dry = 0; hipLaunchKernelGGL(mk, dim3(grid), dim3(NTHR), LDS_BYTES, stream, a); }
#else
    a.ph_lo = 0; a.ph_hi = N_PHASES;
    hipLaunchKernelGGL(mk, dim3(grid), dim3(NTHR), LDS_BYTES, stream, a);
#endif
}
```
